# Optimizing an MI355X kernel written in HIP

```python
import numpy as np
import jax, jax.numpy as jnp
from jax import lax


D_MODEL = 1024
BATCH = 32
SEQ = 2048
DEPTH = 4

N_MIXERS = 3
GRID_W = 64
PLE_DIM = 256
RMS_EPS = 1e-6
LN_EPS = 1e-5
NEG = -1e30
HEAD_DIM = 64
MIX_WIDTH = 1024
A_WIDTH = 1024
A_GROUPS = 8
A_CHUNK = 128
B_HEADS = 16
B_KV_HEADS = 4
B_WINDOW = 128
B_BLOCK = 128
C_HEADS = 16
C_WIN_ROWS = 8
C_WIN_COLS = 16
C_QCOLS = 16
C_KCOLS = C_QCOLS + C_WIN_COLS
N_EXPERTS = 16
EXPERT_FF = 1024
EC_CAPACITY_FACTOR = 2
N_A = len(range(0, DEPTH, N_MIXERS))
N_B = len(range(1, DEPTH, N_MIXERS))
N_C = len(range(2, DEPTH, N_MIXERS))

kernel_name = 'hybrid_gmlp_swa_natten_ec_encoder'


def rms_norm(x, g):
    xf = x.astype(jnp.float32)
    y = xf * lax.rsqrt(jnp.mean(xf * xf, axis=-1, keepdims=True) + RMS_EPS)
    return (y * g.astype(jnp.float32)).astype(x.dtype)


def layer_norm(x, g):
    xf = x.astype(jnp.float32)
    mu = jnp.mean(xf, axis=-1, keepdims=True)
    var = jnp.mean(jnp.square(xf - mu), axis=-1, keepdims=True)
    return ((xf - mu) * lax.rsqrt(var + LN_EPS) * g.astype(jnp.float32)).astype(x.dtype)


def mixer_a(xn, w_in, vnorm_g, w_s, b_s):
    b_, s_, _ = xn.shape
    z = jax.nn.gelu(xn @ w_in)
    u, v = jnp.split(z, 2, axis=-1)
    v = layer_norm(v, vnorm_g)
    v = v.reshape(b_, s_ // A_CHUNK, A_CHUNK, A_GROUPS, A_WIDTH // A_GROUPS)
    s = jnp.einsum('gts,bnsgc->bntgc', w_s, v) + b_s.T[:, :, None]
    return u * s.reshape(b_, s_, A_WIDTH)


def alibi_slopes(n):
    return np.array([2.0 ** (-8.0 * (h + 1) / n) for h in range(n)], dtype=np.float32)


def mixer_b(xn, w_in, qn_g, kn_g, sink):
    b_, s_, _ = xn.shape
    grp = B_HEADS // B_KV_HEADS
    qkv = xn @ w_in
    q, k, v = jnp.split(qkv, [B_HEADS * HEAD_DIM, (B_HEADS + B_KV_HEADS) * HEAD_DIM], axis=-1)
    q = rms_norm(q.reshape(b_, s_, B_KV_HEADS, grp, HEAD_DIM), qn_g)
    k = rms_norm(k.reshape(b_, s_, B_KV_HEADS, HEAD_DIM), kn_g)
    v = v.reshape(b_, s_, B_KV_HEADS, HEAD_DIM)
    pad = ((0, 0), (B_BLOCK, B_BLOCK), (0, 0), (0, 0))
    kp = jnp.pad(k, pad)
    vp = jnp.pad(v, pad)
    span = 3 * B_BLOCK
    rel = np.arange(span)[None, :] - B_BLOCK - np.arange(B_BLOCK)[:, None]
    in_window = jnp.asarray(np.abs(rel) <= B_WINDOW)
    alibi = jnp.asarray((-alibi_slopes(B_HEADS).reshape(B_KV_HEADS, grp, 1, 1)
                         * np.abs(rel)[None, None]).astype(np.float32))
    sink_f = sink.astype(jnp.float32).reshape(B_KV_HEADS, grp)[None, :, :, None]
    scale = HEAD_DIM ** -0.5

    def block(n):
        t0 = n * B_BLOCK
        qb = lax.dynamic_slice_in_dim(q, t0, B_BLOCK, axis=1)
        kb = lax.dynamic_slice_in_dim(kp, t0, span, axis=1)
        vb = lax.dynamic_slice_in_dim(vp, t0, span, axis=1)
        s = jnp.einsum('bqhgd,bkhd->bhgqk', qb, kb,
                       preferred_element_type=jnp.float32) * scale + alibi
        kpos = t0 - B_BLOCK + jnp.arange(span)
        valid = in_window & ((kpos >= 0) & (kpos < s_))[None, :]
        s = jnp.where(valid, s, NEG)
        m = jnp.maximum(s.max(axis=-1), sink_f)
        pe = jnp.exp(s - m[..., None])
        denom = pe.sum(axis=-1) + jnp.exp(sink_f - m)
        o = jnp.einsum('bhgqk,bkhd->bqhgd', pe, vb.astype(jnp.float32))
        o = o / denom.transpose(0, 3, 1, 2)[..., None]
        return o.astype(xn.dtype)

    out = lax.map(block, jnp.arange(s_ // B_BLOCK))
    return out.transpose(1, 0, 2, 3, 4, 5).reshape(b_, s_, B_HEADS * HEAD_DIM)


def natten_tables(w):
    ncb = w // C_QCOLS
    c = np.arange(w).reshape(ncb, C_QCOLS)
    cs = np.clip(c - C_WIN_COLS // 2, 0, w - C_WIN_COLS)
    kb = np.clip(np.arange(ncb) * C_QCOLS - C_WIN_COLS // 2, 0, w - C_KCOLS)
    kcol = kb[:, None] + np.arange(C_KCOLS)[None, :]
    colmask = (kcol[:, None, :] >= cs[:, :, None]) & (kcol[:, None, :] < cs[:, :, None] + C_WIN_COLS)
    coloff = np.clip(kcol[:, None, :] - c[:, :, None] + C_WIN_COLS - 1, 0, 2 * C_WIN_COLS - 2)
    return kcol, colmask, coloff


def mixer_c(xn, w_in, qn_g, kn_g, rpb):
    b_, s_, _ = xn.shape
    rows = s_ // GRID_W
    kr_n = min(C_WIN_ROWS, rows)
    ncb = GRID_W // C_QCOLS
    qkv = xn @ w_in
    q, k, v = jnp.split(qkv, 3, axis=-1)
    q = rms_norm(q.reshape(b_, rows, GRID_W, C_HEADS, HEAD_DIM), qn_g)
    k = rms_norm(k.reshape(b_, rows, GRID_W, C_HEADS, HEAD_DIM), kn_g)
    v = v.reshape(b_, rows, GRID_W, C_HEADS, HEAD_DIM)
    kcol, colmask, coloff = natten_tables(GRID_W)
    colmask_j = jnp.asarray(colmask)[None, None, :, :, None, :]
    rpb_f = rpb.astype(jnp.float32)
    scale = HEAD_DIM ** -0.5

    def row(r):
        rs = jnp.clip(r - kr_n // 2, 0, rows - kr_n)
        qr = lax.dynamic_index_in_dim(q, r, axis=1, keepdims=False)
        qr = qr.reshape(b_, ncb, C_QCOLS, C_HEADS, HEAD_DIM)
        kr = lax.dynamic_slice_in_dim(k, rs, kr_n, axis=1)[:, :, kcol]
        vr = lax.dynamic_slice_in_dim(v, rs, kr_n, axis=1)[:, :, kcol]
        s = jnp.einsum('bnqhd,brnkhd->bhnqrk', qr, kr,
                       preferred_element_type=jnp.float32) * scale
        row_idx = rs + jnp.arange(kr_n) - r + C_WIN_ROWS - 1
        bias = rpb_f[:, row_idx][:, :, coloff]
        s = s + bias.transpose(0, 2, 3, 1, 4)[None]
        s = jnp.where(colmask_j, s, NEG)
        s = s.reshape(b_, C_HEADS, ncb, C_QCOLS, kr_n * C_KCOLS)
        pr = jax.nn.softmax(s, axis=-1).reshape(b_, C_HEADS, ncb, C_QCOLS, kr_n, C_KCOLS)
        o = jnp.einsum('bhnqrk,brnkhd->bnqhd', pr, vr.astype(jnp.float32))
        return o.reshape(b_, GRID_W, C_HEADS * HEAD_DIM).astype(xn.dtype)

    out = lax.map(row, jnp.arange(rows))
    return out.transpose(1, 0, 2, 3).reshape(b_, s_, C_HEADS * HEAD_DIM)


def expert_choice_ffn(xn, router_w, w_gate, w_up, w_down):
    b_, s_, _ = xn.shape
    cap = max(1, EC_CAPACITY_FACTOR * s_ // N_EXPERTS)
    aff = jax.nn.softmax((xn @ router_w).astype(jnp.float32), axis=-1)
    gates, idx = lax.top_k(aff.transpose(0, 2, 1), cap)
    bidx = jnp.arange(b_)[:, None, None]
    xs = xn[bidx, idx]
    hdn = jax.nn.silu(jnp.einsum('becd,edf->becf', xs, w_gate)) * jnp.einsum('becd,edf->becf', xs, w_up)
    y = jnp.einsum('becf,efd->becd', hdn, w_down) * gates[..., None].astype(xn.dtype)
    return jnp.zeros_like(xn).at[bidx, idx].add(y)


def setup_inputs(seed: int = 0) -> dict:
    key = jax.random.key(seed)
    ks = iter(jax.random.split(key, 32))
    f32 = jnp.float32
    nrm = lambda shape, s: jax.random.normal(next(ks), shape, f32) * s
    gain = lambda shape: 1.0 + nrm(shape, 0.05)
    d = D_MODEL
    return {
        'x': nrm((BATCH, SEQ, d), 1.0),
        'p': nrm((DEPTH, BATCH, SEQ, PLE_DIM), 1.0),
        'norm_mix_g': gain((DEPTH, d)),
        'norm_ffn_g': gain((DEPTH, d)),
        'w_out': nrm((DEPTH, MIX_WIDTH, d), MIX_WIDTH ** -0.5),
        'router_w': nrm((DEPTH, d, N_EXPERTS), d ** -0.5),
        'exp_w_gate': nrm((DEPTH, N_EXPERTS, d, EXPERT_FF), d ** -0.5),
        'exp_w_up': nrm((DEPTH, N_EXPERTS, d, EXPERT_FF), d ** -0.5),
        'exp_w_down': nrm((DEPTH, N_EXPERTS, EXPERT_FF, d), EXPERT_FF ** -0.5),
        'ple_norm_g': gain((DEPTH, d)),
        'ple_gate_w': nrm((DEPTH, d, d), d ** -0.5),
        'ple_proj_w': nrm((DEPTH, PLE_DIM, d), PLE_DIM ** -0.5),
        'a_w_in': nrm((N_A, d, 2 * A_WIDTH), d ** -0.5),
        'a_vnorm_g': gain((N_A, A_WIDTH)),
        'a_w_s': nrm((N_A, A_GROUPS, A_CHUNK, A_CHUNK), A_CHUNK ** -0.5),
        'a_b_s': 1.0 + nrm((N_A, A_GROUPS, A_CHUNK), 0.1),
        'b_w_in': nrm((N_B, d, (B_HEADS + 2 * B_KV_HEADS) * HEAD_DIM), d ** -0.5),
        'b_qnorm_g': gain((N_B, HEAD_DIM)),
        'b_knorm_g': gain((N_B, HEAD_DIM)),
        'b_sink': nrm((N_B, B_HEADS), 0.5),
        'c_w_in': nrm((N_C, d, 3 * C_HEADS * HEAD_DIM), d ** -0.5),
        'c_qnorm_g': gain((N_C, HEAD_DIM)),
        'c_knorm_g': gain((N_C, HEAD_DIM)),
        'c_rpb': nrm((N_C, C_HEADS, 2 * C_WIN_ROWS - 1, 2 * C_WIN_COLS - 1), 0.1),
    }


def reference(x, p, norm_mix_g, norm_ffn_g, w_out, router_w, exp_w_gate, exp_w_up, exp_w_down,
              ple_norm_g, ple_gate_w, ple_proj_w, a_w_in, a_vnorm_g, a_w_s, a_b_s,
              b_w_in, b_qnorm_g, b_knorm_g, b_sink, c_w_in, c_qnorm_g, c_knorm_g, c_rpb):
    h = x
    for i in range(DEPTH):
        kind = i % N_MIXERS
        j = i // N_MIXERS
        xn = rms_norm(h, norm_mix_g[i])
        if kind == 0:
            mix = mixer_a(xn, a_w_in[j], a_vnorm_g[j], a_w_s[j], a_b_s[j])
        elif kind == 1:
            mix = mixer_b(xn, b_w_in[j], b_qnorm_g[j], b_knorm_g[j], b_sink[j])
        else:
            mix = mixer_c(xn, c_w_in[j], c_qnorm_g[j], c_knorm_g[j], c_rpb[j])
        h = h + mix @ w_out[i]
        h = h + expert_choice_ffn(rms_norm(h, norm_ffn_g[i]), router_w[i],
                                  exp_w_gate[i], exp_w_up[i], exp_w_down[i])
        gate = jax.nn.sigmoid(rms_norm(h, ple_norm_g[i]) @ ple_gate_w[i])
        h = h + gate * (p[i] @ ple_proj_w[i])
    return h
```

```cpp
#include <hip/hip_runtime.h>
#include <cstdio>
#include <cstdint>

#ifndef MK_ONE_LAUNCH
#define MK_ONE_LAUNCH 1
#endif

#ifndef FP8_IN_MASK
#define FP8_IN_MASK 0x6
#endif
#define GAS __attribute__((address_space(1)))
#define LAS __attribute__((address_space(3)))
typedef unsigned short bf16;
typedef short bf16x8 __attribute__((ext_vector_type(8)));
typedef short s16x4 __attribute__((ext_vector_type(4)));
typedef float f32x4 __attribute__((ext_vector_type(4)));
typedef float f32x2 __attribute__((ext_vector_type(2)));
typedef float f32x16 __attribute__((ext_vector_type(16)));
typedef unsigned u32x4 __attribute__((ext_vector_type(4)));
typedef unsigned u32x2 __attribute__((ext_vector_type(2)));
typedef __bf16 bf16x2_t __attribute__((ext_vector_type(2)));

constexpr int D = 1024, NBATCH = 32, SEQ = 2048, T = NBATCH * SEQ, DEPTH = 4, PLE = 256, NE = 16, FF = 1024, CAP = 256;
constexpr int M2 = NBATCH * NE * CAP;
constexpr int NWAVES = 8, NTHREADS = 512;
constexpr float RMS_EPS = 1e-6f, LN_EPS = 1e-5f, LOG2E = 1.4426950408889634f;

constexpr size_t MiB = 1u << 20;
constexpr size_t WS_CTL = 0, CTL_ZERO_BYTES = 1 * MiB;
constexpr size_t WS_AFF = 1 * MiB;
constexpr size_t WS_IDX = 5 * MiB;
constexpr size_t WS_GATEV = 5 * MiB + 512 * 1024;
constexpr size_t WS_SLOT = 6 * MiB;
constexpr size_t WS_WSA = 10 * MiB;
constexpr size_t WS_RSTD1 = 10 * MiB + 512 * 1024;
constexpr size_t WS_RSTD3 = 10 * MiB + 768 * 1024;
constexpr size_t WS_RSTD = 11 * MiB;
constexpr size_t WS_RSEL = 11 * MiB + 512 * 1024;
constexpr size_t WS_W = 12 * MiB, WL_STRIDE = 107 * MiB;
constexpr size_t WL_IN = 0, WL_OUT = 6 * MiB, WL_GU = 8 * MiB, WL_DN = 72 * MiB, WL_PG = 104 * MiB, WL_PP = 106 * MiB;
constexpr size_t WS_VST = WS_W + 1 * WL_STRIDE + WL_GU + 32 * MiB;
constexpr size_t WS_XN = WS_W + 4 * WL_STRIDE;
constexpr size_t WS_R1 = WS_XN + 128 * MiB;
constexpr size_t WS_R2 = WS_R1 + 384 * MiB;
constexpr size_t WS_END = WS_R2 + 256 * MiB;
constexpr int CW_BAR = 4096;

constexpr int LDS_BYTES = 160 * 1024;
constexpr int MISC_OFF = LDS_BYTES - 256;
constexpr int LDS_SPARE = 131072;

#define LDS_WAIT() asm volatile("s_waitcnt lgkmcnt(0)" ::: "memory")
#define VM_WAIT() asm volatile("s_waitcnt vmcnt(0)" ::: "memory")
__device__ __forceinline__ unsigned pk2(float lo, float hi) { f32x2 v = {lo, hi}; bf16x2_t b = __builtin_convertvector(v, bf16x2_t); return __builtin_bit_cast(unsigned, b); }
__device__ __forceinline__ float bf_lo(unsigned w) { return __uint_as_float(w << 16); }
__device__ __forceinline__ float bf_hi(unsigned w) { return __uint_as_float(w & 0xffff0000u); }
__device__ __forceinline__ float bf1(bf16 b) { return __uint_as_float(((unsigned)b) << 16); }
__device__ __forceinline__ bf16 f2bf(float f) { return (bf16)(pk2(f, 0.f) & 0xffffu); }
template <int M> __device__ __forceinline__ float xshfl(float v) { return __int_as_float(__builtin_amdgcn_ds_swizzle(__float_as_int(v), (M << 10) | 0x1f)); }
__device__ __forceinline__ float sum32x(float v) { auto r = __builtin_amdgcn_permlane32_swap(__float_as_uint(v), __float_as_uint(v), false, false); return __uint_as_float(r[0]) + __uint_as_float(r[1]); }
__device__ __forceinline__ float max32x(float v) { auto r = __builtin_amdgcn_permlane32_swap(__float_as_uint(v), __float_as_uint(v), false, false); return fmaxf(__uint_as_float(r[0]), __uint_as_float(r[1])); }
__device__ __forceinline__ float wave_sum(float v) { v += xshfl<1>(v); v += xshfl<2>(v); v += xshfl<4>(v); v += xshfl<8>(v); v += xshfl<16>(v); return sum32x(v); }
__device__ __forceinline__ float wave_max(float v) { v = fmaxf(v, xshfl<1>(v)); v = fmaxf(v, xshfl<2>(v)); v = fmaxf(v, xshfl<4>(v)); v = fmaxf(v, xshfl<8>(v)); v = fmaxf(v, xshfl<16>(v)); return max32x(v); }
__device__ __forceinline__ unsigned opaque(unsigned x) { asm volatile("" : "+v"(x)); return x; }
typedef const float* cfp0_t;
typedef const __attribute__((address_space(4))) cfp0_t* kin0_t;
__device__ __forceinline__ kin0_t opaque_k(kin0_t p) { unsigned long long v = (unsigned long long)p; unsigned lo = (unsigned)v, hi = (unsigned)(v >> 32); asm volatile("" : "+v"(lo), "+v"(hi));
    lo = __builtin_amdgcn_readfirstlane(lo); hi = __builtin_amdgcn_readfirstlane(hi); return (kin0_t)(((unsigned long long)hi << 32) | lo); }
template <class P> __device__ __forceinline__ P* opaque_p(P* p) { unsigned long long v = (unsigned long long)p; unsigned lo = (unsigned)v, hi = (unsigned)(v >> 32); asm volatile("" : "+v"(lo), "+v"(hi));
    lo = __builtin_amdgcn_readfirstlane(lo); hi = __builtin_amdgcn_readfirstlane(hi); return (P*)(GAS P*)(((unsigned long long)hi << 32) | lo); }
__device__ __forceinline__ int lane_id() { int l; asm volatile("v_mbcnt_lo_u32_b32 %0, -1, 0\n\tv_mbcnt_hi_u32_b32 %0, -1, %0" : "=v"(l)); return l; }
__device__ __forceinline__ int opaque_i(int x) { asm volatile("" : "+v"(x)); return x; }
__device__ __forceinline__ u32x2 pack8_fp8(const float (&x)[8]) {
    unsigned a = 0u, b = 0u;
    a = (unsigned)__builtin_amdgcn_cvt_pk_fp8_f32(x[0], x[1], (int)a, false); a = (unsigned)__builtin_amdgcn_cvt_pk_fp8_f32(x[2], x[3], (int)a, true);
    b = (unsigned)__builtin_amdgcn_cvt_pk_fp8_f32(x[4], x[5], (int)b, false); b = (unsigned)__builtin_amdgcn_cvt_pk_fp8_f32(x[6], x[7], (int)b, true);
    u32x2 r; r.x = a; r.y = b; return r;
}
__device__ __forceinline__ void unpack8_fp8(const u32x2 w, float (&x)[8]) {
    const f32x2 a = __builtin_amdgcn_cvt_pk_f32_fp8((int)w.x, false), b = __builtin_amdgcn_cvt_pk_f32_fp8((int)w.x, true), c = __builtin_amdgcn_cvt_pk_f32_fp8((int)w.y, false), d = __builtin_amdgcn_cvt_pk_f32_fp8((int)w.y, true);
    x[0] = a[0]; x[1] = a[1]; x[2] = b[0]; x[3] = b[1]; x[4] = c[0]; x[5] = c[1]; x[6] = d[0]; x[7] = d[1];
}
__device__ __forceinline__ float fexp2(float x) { return __builtin_amdgcn_exp2f(x); }
__device__ __forceinline__ float frcp(float x) { return __builtin_amdgcn_rcpf(x); }

namespace pg8 {
constexpr int BM = 256, BK = 64, HALF = 128, HTB = HALF * BK * 2, STAGE_BYTES = 8 * HTB, NXCD = 8, WGM = 8;
__host__ __device__ __forceinline__ int lds_byte(int r, int c) { const int st = (r >> 4) * 2 + (c >> 5), rr = r & 15, cc = c & 31, ob = rr * 64 + cc * 2; return st * 1024 + (ob ^ (((ob >> 9) & 1) << 5)); }
__host__ __device__ __forceinline__ void stage_rc(int b, int& R, int& C) { const int st = b / 1024, sb = b % 1024, swz = sb ^ (((sb >> 9) & 1) << 5); R = (st >> 1) * 16 + swz / 64; C = (st & 1) * 32 + (swz % 64) / 2; }
__host__ __device__ __forceinline__ int perm32(int rho) { const int n = rho >> 4, i = rho & 15; return 8 * (i >> 2) + 4 * n + (i & 3); }

__device__ __forceinline__ void glds16(const char* sbase, unsigned voff, unsigned lds_dst) {
    unsigned keep;
    asm volatile("s_mov_b32 %0, m0\n\ts_mov_b32 m0, %3\n\ts_nop 0\n\tglobal_load_lds_dwordx4 %1, %2\n\ts_mov_b32 m0, %0" : "=&s"(keep) : "v"(voff), "s"(sbase), "s"(lds_dst) : "memory");
}
struct Unit { int pm, pn; };

struct StaticOrder {
    const char* A; const char* Bt; size_t tstep;
    int nM, nN, nwg, G, c;
    __device__ void init(const void* A_, const void* Bt_, int M, int N, int K, int G_, int c_) { A = (const char*)A_; Bt = (const char*)Bt_; tstep = (size_t)BM * K * 2; nM = M / BM; nN = N / BM; nwg = nM * nN; G = G_; c = c_; }
    __device__ __forceinline__ bool next(int i, Unit& u) const {
        const long L = (long)i * G + c; if (L >= nwg) return false;
        int wgid = (int)L; { const int q = nwg / NXCD, r = nwg % NXCD, xcd = wgid % NXCD, off = wgid / NXCD; wgid = (xcd < r ? xcd * (q + 1) : r * (q + 1) + (xcd - r) * q) + off; }
        const int nig = WGM * nN, gid = wgid / nig, fm = gid * WGM, gsz = (nM - fm) < WGM ? (nM - fm) : WGM;
        u.pm = fm + ((wgid % nig) % gsz); u.pn = (wgid % nig) / gsz; return true;
    }
    __device__ __forceinline__ const char* a_ptr(const Unit& u) const { return A + (size_t)u.pm * tstep; }
    __device__ __forceinline__ const char* b_ptr(const Unit& u) const { return Bt + (size_t)u.pn * tstep; }
};
struct GroupedOrder {
    const char* A; const char* Bt; size_t tstep, estride;
    int NT, nunits, G, c; size_t bstride;
    __device__ void init(const void* A_, const void* Bt_, int K, int NT_, size_t estride_bytes, int G_, int c_, size_t bstride_ = 0) { A = (const char*)A_; Bt = (const char*)Bt_; tstep = (size_t)BM * K * 2; estride = estride_bytes; NT = NT_; nunits = NBATCH * NE * NT_; G = G_; c = c_; bstride = bstride_; }
    __device__ __forceinline__ bool next(int i, Unit& u) const {
        const long L = (long)i * G + c; if (L >= nunits) return false;
        const int x = (int)L & 7, q = (int)L >> 3, s = q & 31, ii = q >> 5;
        const int e = 2 * x + ii / NT, j = ii % NT, pn = s % NT, b = (32 / NT) * j + s / NT;
        u.pm = b * NE + e; u.pn = pn; return true;
    }
    __device__ __forceinline__ const char* a_ptr(const Unit& u) const { return bstride ? A + (size_t)(u.pm >> 4) * bstride : A + (size_t)u.pm * tstep; }
    __device__ __forceinline__ const char* b_ptr(const Unit& u) const { return Bt + (size_t)(u.pm & (NE - 1)) * estride + (size_t)u.pn * tstep; }
};

struct PanelOrder {
    const char* A; const char* Bt; size_t tstep; int nN, nP, G, c;
    __device__ void init(const void* A_, const void* Bt_, int K, int nP_, int nN_, int G_, int c_) { A = (const char*)A_; Bt = (const char*)Bt_; tstep = (size_t)BM * K * 2; nN = nN_; nP = nP_; G = G_; c = c_; }
    __device__ __forceinline__ bool next(int i, Unit& u) const { const int pm = c + (i / nN) * G; if (pm >= nP) return false; u.pm = pm; u.pn = i % nN; return true; }
    __device__ __forceinline__ const char* a_ptr(const Unit& u) const { return A + (size_t)u.pm * tstep; }
    __device__ __forceinline__ const char* b_ptr(const Unit& u) const { return Bt + (size_t)u.pn * tstep; }
};
struct FixedTileOrder : GroupedOrder {
    __device__ __forceinline__ const char* a_ptr(const Unit&) const { return Bt; }
    __device__ __forceinline__ const char* b_ptr(const Unit&) const { return Bt; }
};
typedef f32x4 Acc[2][2][4][2];

constexpr int FP8_WEXP = 6;
#ifndef PG8_ALIGN_DEF
#define PG8_ALIGN_DEF true
#endif
#ifndef PG8_SP2_DEF
#define PG8_SP2_DEF true
#endif
template <class Epi, class Sched, bool GATHER = false, bool FP8 = false, bool ALIGN_EPI = PG8_ALIGN_DEF, bool SP2 = PG8_SP2_DEF>
__device__ __forceinline__ void gemm_phase(LAS unsigned char* lds, const int wave_id, const int K, const Sched& S, const Epi& E, const LAS unsigned short* gtab = nullptr) {
    const int lane = opaque_i(lane_id()), wid = __builtin_amdgcn_readfirstlane(opaque_i(wave_id)), tid = wid * 64 + lane, wr = wid >> 2, wc = wid & 3, fr = lane & 15, fq = lane >> 4;
    const int nt = K / BK;
    unsigned voffA[2], voffB[2]; int gR[2];
#pragma unroll
    for (int i = 0; i < 2; ++i) { int R, C; stage_rc(tid * 16 + i * 8192, R, C); const int Rb = Epi::PERM ? ((R & ~31) + perm32(R & 31)) : R;
        voffA[i] = GATHER ? (unsigned)C * 2u : (unsigned)(R * K + C) * 2u; voffB[i] = (unsigned)(Rb * K + C) * 2u; gR[i] = R; }
    unsigned vC[2][2];
    const size_t kstep = (size_t)(BK * 2);
    const size_t hstep = (size_t)HALF * K * 2;
    const unsigned ldsw = (unsigned)wid * 1024u, ldsb = (unsigned)(size_t)lds;
    const int aoff = lds_byte(wr * 64 + fr, fq * 8), boff = lds_byte(wc * 32 + fr, fq * 8);
#define PG8_SA(b, h) (((b) * 2 + (h)) * HTB)
#define PG8_SB(b, h) ((4 + (b) * 2 + (h)) * HTB)
#define PG8_STAGE(bufoff, gbase, voff) do { _Pragma("unroll") for (int _i = 0; _i < 2; ++_i) glds16((const char*)(gbase), (voff)[_i], ldsb + (unsigned)(bufoff) + ldsw + (unsigned)(_i * 8192)); } while (0)
#define PG8_STAGE_A(bufoff, gbase, h, nx) do { _Pragma("unroll") for (int _i = 0; _i < 2; ++_i) { \
        if constexpr (GATHER) glds16((const char*)(gbase), vC[h][_i], ldsb + (unsigned)(bufoff) + ldsw + (unsigned)(_i * 8192)); \
        else glds16((const char*)(gbase) + (size_t)(h) * hstep, voffA[_i], ldsb + (unsigned)(bufoff) + ldsw + (unsigned)(_i * 8192)); } } while (0)
#define PG8_GLOAD(dst, ui_) do { _Pragma("unroll") for (int h_ = 0; h_ < 2; ++h_) _Pragma("unroll") for (int i_ = 0; i_ < 2; ++i_) dst[h_][i_] = ((unsigned)gtab[(ui_) * 256 + h_ * HALF + gR[i_]] << 10) + voffA[i_]; } while (0)
#define PG8_LDA(dst, b, h) do { if constexpr (FP8) { _Pragma("unroll") for (int m = 0; m < 4; ++m) { const v4i_ p0_ = *(const LAS v4i_*)(lds + PG8_SA(b, h) + aoff + m * 2048), p1_ = *(const LAS v4i_*)(lds + PG8_SA(b, h) + aoff + m * 2048 + 1024); \
            dst##8[m] = __builtin_shufflevector(p0_, p1_, 0, 1, 2, 3, 4, 5, 6, 7); } } \
        else { _Pragma("unroll") for (int m = 0; m < 4; ++m) _Pragma("unroll") for (int k = 0; k < 2; ++k) dst[m][k] = *(const LAS bf16x8*)(lds + PG8_SA(b, h) + aoff + m * 2048 + k * 1024); } } while (0)
#define PG8_LDB(dst, b, h) do { if constexpr (FP8) { _Pragma("unroll") for (int n = 0; n < 2; ++n) { const v4i_ p0_ = *(const LAS v4i_*)(lds + PG8_SB(b, h) + boff + n * 2048), p1_ = *(const LAS v4i_*)(lds + PG8_SB(b, h) + boff + n * 2048 + 1024); \
            dst##8[n] = __builtin_shufflevector(p0_, p1_, 0, 1, 2, 3, 4, 5, 6, 7); } } \
        else { _Pragma("unroll") for (int n = 0; n < 2; ++n) _Pragma("unroll") for (int k = 0; k < 2; ++k) dst[n][k] = *(const LAS bf16x8*)(lds + PG8_SB(b, h) + boff + n * 2048 + k * 1024); } } while (0)
#define PG8_MMA(ai, bj, At, Bt) do { __builtin_amdgcn_s_setprio(1); _Pragma("unroll") for (int m = 0; m < 4; ++m) _Pragma("unroll") for (int n = 0; n < 2; ++n) { \
        if constexpr (FP8) asm volatile("v_mfma_scale_f32_16x16x128_f8f6f4 %0, %1, %2, %0, %3, %4 op_sel_hi:[0,0,0]" : "+v"(acc[ai][bj][m][n]) : "v"(Bt##8[n]), "v"(At##8[m]), "v"(fp8_sw), "v"(fp8_sa)); \
        else { _Pragma("unroll") for (int k = 0; k < 2; ++k) acc[ai][bj][m][n] = __builtin_amdgcn_mfma_f32_16x16x32_bf16(Bt[n][k], At[m][k], acc[ai][bj][m][n], 0, 0, 0); } } \
        __builtin_amdgcn_s_setprio(0); } while (0)
#define PG8_WAIT_V(n) asm volatile("s_waitcnt vmcnt(" #n ")" ::: "memory")
#define PG8_WAIT_L(n) asm volatile("s_waitcnt lgkmcnt(" #n ")" ::: "memory")
#define PG8_BAR __builtin_amdgcn_s_barrier()
#define PG8_SCHED __builtin_amdgcn_sched_barrier(0)
    Unit cur, nxt; int ui = 0;
    if (!S.next(0, cur)) return;
    Acc acc;
#pragma unroll
    for (int a = 0; a < 2; ++a)
#pragma unroll
        for (int b = 0; b < 2; ++b)
#pragma unroll
            for (int m = 0; m < 4; ++m)
#pragma unroll
                for (int n = 0; n < 2; ++n) acc[a][b][m][n] = (f32x4){0.f, 0.f, 0.f, 0.f};
    typedef int v8i_ __attribute__((ext_vector_type(8))); typedef int v4i_ __attribute__((ext_vector_type(4)));
    bf16x8 At[4][2], B0[2][2], B1[2][2];
    v8i_ At8[4], B08[2], B18[2];
    const int fp8_sw = (int)(0x01010101u * (127u - FP8_WEXP)), fp8_sa = 0x7F7F7F7F; (void)fp8_sw; (void)fp8_sa;
    const char* cA = S.a_ptr(cur); const char* cB = S.b_ptr(cur);
    if constexpr (GATHER) { PG8_GLOAD(vC, 0); }
    if constexpr (SP2) {
        PG8_STAGE(PG8_SB(0, 0), cB, voffB); PG8_STAGE(PG8_SB(0, 1), cB + hstep, voffB); PG8_STAGE_A(PG8_SA(0, 0), cA, 0, false); PG8_STAGE_A(PG8_SA(0, 1), cA, 1, false);
        if (wr == 1) PG8_BAR;
        PG8_WAIT_V(2); PG8_BAR;
        PG8_STAGE(PG8_SB(1, 0), cB + kstep, voffB); PG8_STAGE_A(PG8_SA(1, 0), cA + kstep, 0, false); PG8_STAGE(PG8_SB(1, 1), cB + hstep + kstep, voffB);
        PG8_WAIT_V(6); PG8_BAR;
    } else {
        PG8_STAGE(PG8_SB(0, 0), cB, voffB); PG8_STAGE_A(PG8_SA(0, 0), cA, 0, false); PG8_STAGE(PG8_SB(0, 1), cB + hstep, voffB); PG8_STAGE_A(PG8_SA(0, 1), cA, 1, false);
        if (wr == 1) PG8_BAR;
        PG8_WAIT_V(4); PG8_BAR;
        PG8_STAGE(PG8_SB(1, 0), cB + kstep, voffB); PG8_STAGE_A(PG8_SA(1, 0), cA + kstep, 0, false); PG8_STAGE(PG8_SB(1, 1), cB + hstep + kstep, voffB);
        PG8_WAIT_V(6); PG8_BAR;
    }
    for (;;) {
        const bool has_next = S.next(ui + 1, nxt);
        const char* nA = has_next ? S.a_ptr(nxt) : cA; const char* nB = has_next ? S.b_ptr(nxt) : cB;
#pragma unroll 1
        for (int t = 0; t < nt; t += 2) {
            const bool last = (t == nt - 2);
            const char* a1 = cA + (size_t)(t + 1) * kstep;
            const char* a2 = last ? nA : cA + (size_t)(t + 2) * kstep; const char* b2 = last ? nB : cB + (size_t)(t + 2) * kstep;
            const char* a3 = a2 + kstep; const char* b3 = b2 + kstep;
            if constexpr (SP2) {
            PG8_LDB(B0, 0, 0); PG8_LDB(B1, 0, 1); PG8_SCHED; PG8_LDA(At, 0, 0); PG8_STAGE_A(PG8_SA(1, 1), a1, 1, false);
            if constexpr (GATHER) { if (last && has_next) { PG8_GLOAD(vC, ui + 1); } }
            PG8_WAIT_V(8); PG8_WAIT_L(0); PG8_BAR; PG8_MMA(0, 0, At, B0); PG8_MMA(0, 1, At, B1); PG8_BAR; PG8_SCHED;
            PG8_LDA(At, 0, 1); PG8_STAGE(PG8_SB(0, 0), b2, voffB); PG8_STAGE(PG8_SB(0, 1), b2 + hstep, voffB); PG8_STAGE_A(PG8_SA(0, 0), a2, 0, last);
            PG8_WAIT_V(8); PG8_WAIT_L(0); PG8_BAR; PG8_MMA(1, 0, At, B0); PG8_MMA(1, 1, At, B1); PG8_BAR; PG8_SCHED;
            PG8_LDB(B0, 1, 0); PG8_LDB(B1, 1, 1); PG8_SCHED; PG8_LDA(At, 1, 0); PG8_STAGE_A(PG8_SA(0, 1), a2, 1, last);
            PG8_WAIT_V(8); PG8_WAIT_L(0); PG8_BAR; PG8_MMA(0, 0, At, B0); PG8_MMA(0, 1, At, B1); PG8_BAR; PG8_SCHED;
            PG8_LDA(At, 1, 1); PG8_STAGE(PG8_SB(1, 0), b3, voffB); PG8_STAGE(PG8_SB(1, 1), b3 + hstep, voffB); PG8_STAGE_A(PG8_SA(1, 0), a3, 0, last);
            PG8_WAIT_V(8); PG8_WAIT_L(0); PG8_BAR; PG8_MMA(1, 0, At, B0); PG8_MMA(1, 1, At, B1); PG8_BAR; PG8_SCHED;
            } else {
            PG8_LDB(B0, 0, 0); PG8_SCHED; PG8_LDA(At, 0, 0); PG8_STAGE_A(PG8_SA(1, 1), a1, 1, false);
            if constexpr (GATHER) { if (last && has_next) { PG8_GLOAD(vC, ui + 1); } }
            PG8_WAIT_L(8); PG8_BAR; PG8_WAIT_L(0); PG8_MMA(0, 0, At, B0); PG8_BAR; PG8_SCHED;
            PG8_LDB(B1, 0, 1); PG8_STAGE(PG8_SB(0, 0), b2, voffB);
            PG8_BAR; PG8_WAIT_L(0); PG8_MMA(0, 1, At, B1); PG8_BAR;
            PG8_LDA(At, 0, 1); PG8_STAGE_A(PG8_SA(0, 0), a2, 0, last);
            PG8_BAR; PG8_WAIT_L(0); PG8_MMA(1, 0, At, B0); PG8_BAR; PG8_SCHED;
            PG8_STAGE(PG8_SB(0, 1), b2 + hstep, voffB);
            PG8_WAIT_V(6); PG8_BAR; PG8_MMA(1, 1, At, B1); PG8_BAR;
            PG8_LDB(B0, 1, 0); PG8_SCHED; PG8_LDA(At, 1, 0); PG8_STAGE_A(PG8_SA(0, 1), a2, 1, last);
            PG8_WAIT_L(8); PG8_BAR; PG8_WAIT_L(0); PG8_MMA(0, 0, At, B0); PG8_BAR; PG8_SCHED;
            PG8_LDB(B1, 1, 1); PG8_STAGE(PG8_SB(1, 0), b3, voffB);
            PG8_BAR; PG8_WAIT_L(0); PG8_MMA(0, 1, At, B1); PG8_BAR;
            PG8_LDA(At, 1, 1); PG8_STAGE_A(PG8_SA(1, 0), a3, 0, last);
            PG8_BAR; PG8_WAIT_L(0); PG8_MMA(1, 0, At, B0); PG8_BAR; PG8_SCHED;
            PG8_STAGE(PG8_SB(1, 1), b3 + hstep, voffB);
            PG8_WAIT_V(6); PG8_BAR; PG8_MMA(1, 1, At, B1); PG8_BAR;
            }
        }
        if constexpr (ALIGN_EPI) { if (wr == 0) PG8_BAR; }
        if constexpr (FP8) asm volatile("s_nop 15\n\ts_nop 15" ::: "memory");
        E(acc, cur, wr, wc, ui, fq);
        if (!has_next) break;
#pragma unroll
        for (int a = 0; a < 2; ++a)
#pragma unroll
            for (int b = 0; b < 2; ++b)
#pragma unroll
                for (int m = 0; m < 4; ++m)
#pragma unroll
                    for (int n = 0; n < 2; ++n) acc[a][b][m][n] = (f32x4){0.f, 0.f, 0.f, 0.f};
        cur = nxt; cA = nA; cB = nB; ++ui;
        if constexpr (ALIGN_EPI) { if (wr == 1) PG8_BAR; }
    }
    PG8_WAIT_V(0);
    if constexpr (!ALIGN_EPI) { if (wr == 0) PG8_BAR; }
    PG8_BAR;
#undef PG8_SA
#undef PG8_SB
#undef PG8_STAGE
#undef PG8_STAGE_A
#undef PG8_GLOAD
#undef PG8_LDA
#undef PG8_LDB
#undef PG8_MMA
#undef PG8_WAIT_V
#undef PG8_WAIT_L
#undef PG8_BAR
#undef PG8_SCHED
}

#define EPI_LANE const int lane_ = lane_id(), fr = lane_ & 15, fq = lane_ >> 4; const unsigned lr = opaque((unsigned)(wr * 64 + fr)); const unsigned cw = (unsigned)(wc * 32 + 8 * fq); (void)cw
__device__ __forceinline__ void unpack8(const u32x4 w, float (&x)[8]) { x[0] = bf_lo(w.x); x[1] = bf_hi(w.x); x[2] = bf_lo(w.y); x[3] = bf_hi(w.y); x[4] = bf_lo(w.z); x[5] = bf_hi(w.z); x[6] = bf_lo(w.w); x[7] = bf_hi(w.w); }
__device__ __forceinline__ u32x4 pack8(const float (&x)[8]) { u32x4 w; w.x = pk2(x[0], x[1]); w.y = pk2(x[2], x[3]); w.z = pk2(x[4], x[5]); w.w = pk2(x[6], x[7]); return w; }
template <int ACT> struct EpiIn {
    static constexpr bool PERM = true;
    bf16* O; int ldc; const float* rstd; float* vst;
    __device__ __forceinline__ static float act(float x) {
        if (ACT == 1) { const float u = x * (1.0f + 0.044715f * x * x) * (-2.0f * 0.7978845608028654f * LOG2E); return x * frcp(1.0f + fexp2(u)); }
        return x;
    }
    __device__ __forceinline__ void operator()(const Acc& acc, const Unit& u, int wr, int wc, int, int) const {
        EPI_LANE;
        bf16* op = O + (size_t)u.pm * BM * ldc + (size_t)u.pn * BM; const float* rp = rstd + (size_t)u.pm * BM;
        const bool stats = (ACT == 1) && vst != nullptr && u.pn >= 4;
        float rs[2][4];
#pragma unroll
        for (int ai = 0; ai < 2; ++ai)
#pragma unroll
            for (int m = 0; m < 4; ++m) rs[ai][m] = rp[lr + (unsigned)(ai * HALF + m * 16)];
#pragma unroll
        for (int ai = 0; ai < 2; ++ai)
#pragma unroll
            for (int m = 0; m < 4; ++m) { bf16* rowp = op + ((lr + (unsigned)(ai * HALF + m * 16)) * (unsigned)ldc + cw); const float r = rs[ai][m]; float s1 = 0.f, s2 = 0.f;
#pragma unroll
                for (int bj = 0; bj < 2; ++bj) { const f32x4 v0 = acc[ai][bj][m][0] * r, v1 = acc[ai][bj][m][1] * r;
                    u32x4 w; w.x = pk2(act(v0[0]), act(v0[1])); w.y = pk2(act(v0[2]), act(v0[3])); w.z = pk2(act(v1[0]), act(v1[1])); w.w = pk2(act(v1[2]), act(v1[3]));
                    *(u32x4*)(rowp + bj * HALF) = w;
                    if (ACT == 1) { if (stats) { float y[8]; unpack8(w, y);
#pragma unroll
                        for (int j = 0; j < 8; ++j) { s1 += y[j]; s2 += y[j] * y[j]; } } } }
                if (ACT == 1) { if (stats) { s1 += xshfl<16>(s1); s1 = sum32x(s1); s2 += xshfl<16>(s2); s2 = sum32x(s2);
                    if (fq == 0) { f32x2 st = {s1, s2}; *(f32x2*)(vst + (((size_t)u.pm * BM + lr + (unsigned)(ai * HALF + m * 16)) * 16u + (unsigned)((u.pn - 4) * 4 + wc)) * 2u) = st; } } } }
    }
};
struct EpiRes {
    static constexpr bool PERM = true;
    const bf16* Hin; bf16* Hout;
    __device__ __forceinline__ void operator()(const Acc& acc, const Unit& u, int wr, int wc, int, int) const {
        EPI_LANE;
        const size_t ub = (size_t)u.pm * BM * D + (size_t)u.pn * BM; const bf16* ip = Hin + ub; bf16* op = Hout + ub;
        u32x4 hv[2][4][2];
#pragma unroll
        for (int ai = 0; ai < 2; ++ai)
#pragma unroll
            for (int m = 0; m < 4; ++m)
#pragma unroll
                for (int bj = 0; bj < 2; ++bj) hv[ai][m][bj] = *(const u32x4*)(ip + ((lr + (unsigned)(ai * HALF + m * 16)) * (unsigned)D + cw + (unsigned)(bj * HALF)));
#pragma unroll
        for (int ai = 0; ai < 2; ++ai)
#pragma unroll
            for (int m = 0; m < 4; ++m)
#pragma unroll
                for (int bj = 0; bj < 2; ++bj) { float x[8]; unpack8(hv[ai][m][bj], x); const f32x4 v0 = acc[ai][bj][m][0], v1 = acc[ai][bj][m][1];
                    x[0] += v0[0]; x[1] += v0[1]; x[2] += v0[2]; x[3] += v0[3]; x[4] += v1[0]; x[5] += v1[1]; x[6] += v1[2]; x[7] += v1[3];
                    *(u32x4*)(op + ((lr + (unsigned)(ai * HALF + m * 16)) * (unsigned)D + cw + (unsigned)(bj * HALF))) = pack8(x); }
    }
};
struct EpiGU {
    static constexpr bool PERM = true;
    unsigned char* O; const LAS float* rsel;
    __device__ __forceinline__ void operator()(const Acc& acc, const Unit& u, int wr, int wc, int ui, int) const {
        EPI_LANE;
        unsigned char* op = O + (size_t)u.pm * BM * FF + (size_t)u.pn * HALF; const LAS float* rp = rsel + ui * BM;
        float rs[2][4];
#pragma unroll
        for (int ai = 0; ai < 2; ++ai)
#pragma unroll
            for (int m = 0; m < 4; ++m) rs[ai][m] = rp[lr + (unsigned)(ai * HALF + m * 16)];
#pragma unroll
        for (int ai = 0; ai < 2; ++ai)
#pragma unroll
            for (int m = 0; m < 4; ++m) { const float rr = rs[ai][m]; float r[8];
#pragma unroll
                for (int n = 0; n < 2; ++n)
#pragma unroll
                    for (int j = 0; j < 4; ++j) { const float g = acc[ai][0][m][n][j] * rr, up = acc[ai][1][m][n][j] * rr; r[n * 4 + j] = g * frcp(1.0f + fexp2(-g * LOG2E)) * up; }
                *(u32x2*)(op + ((lr + (unsigned)(ai * HALF + m * 16)) * (unsigned)FF + cw)) = pack8_fp8(r); }
    }
};
struct EpiDown {
    static constexpr bool PERM = true;
    unsigned char* O; const float* gatev;
    __device__ __forceinline__ void operator()(const Acc& acc, const Unit& u, int wr, int wc, int, int) const {
        EPI_LANE;
        unsigned char* op = O + (size_t)u.pm * BM * D + (size_t)u.pn * BM; const float* gp = gatev + (size_t)u.pm * BM;
        float gs[2][4];
#pragma unroll
        for (int ai = 0; ai < 2; ++ai)
#pragma unroll
            for (int m = 0; m < 4; ++m) gs[ai][m] = gp[lr + (unsigned)(ai * HALF + m * 16)];
#pragma unroll
        for (int ai = 0; ai < 2; ++ai)
#pragma unroll
            for (int m = 0; m < 4; ++m)
#pragma unroll
                for (int bj = 0; bj < 2; ++bj) { const f32x4 v0 = acc[ai][bj][m][0] * gs[ai][m], v1 = acc[ai][bj][m][1] * gs[ai][m];
                    const float x[8] = {v0[0], v0[1], v0[2], v0[3], v1[0], v1[1], v1[2], v1[3]};
                    *(u32x2*)(op + ((lr + (unsigned)(ai * HALF + m * 16)) * (unsigned)D + cw + (unsigned)(bj * HALF))) = pack8_fp8(x); }
    }
};
struct EpiProj {
    static constexpr bool PERM = true;
    bf16* O;
    __device__ __forceinline__ void operator()(const Acc& acc, const Unit& u, int wr, int wc, int, int) const {
        EPI_LANE;
        bf16* op = O + (size_t)u.pm * BM * D + (size_t)u.pn * BM;
#pragma unroll
        for (int ai = 0; ai < 2; ++ai)
#pragma unroll
            for (int m = 0; m < 4; ++m)
#pragma unroll
                for (int bj = 0; bj < 2; ++bj) { const f32x4 v0 = acc[ai][bj][m][0], v1 = acc[ai][bj][m][1];
                    u32x4 w; w.x = pk2(v0[0], v0[1]); w.y = pk2(v0[2], v0[3]); w.z = pk2(v1[0], v1[1]); w.w = pk2(v1[2], v1[3]);
                    *(u32x4*)(op + ((lr + (unsigned)(ai * HALF + m * 16)) * (unsigned)D + cw + (unsigned)(bj * HALF))) = w; }
    }
};
struct EpiPle {
    static constexpr bool PERM = true;
    const bf16* Hc; const bf16* proj; bf16* Hn; float* outf; const float* rstd; LAS float* part; int final; unsigned char* hn8;
    __device__ __forceinline__ void operator()(const Acc& acc, const Unit& u, int wr, int wc, int, int) const {
        EPI_LANE;
        const size_t ub = (size_t)u.pm * BM * D + (size_t)u.pn * BM; const bf16* hp = Hc + ub; const bf16* pp = proj + ub; bf16* op = Hn + ub; float* fp = outf + ub; const float* rp = rstd + (size_t)u.pm * BM;
        float rs[2][4];
#pragma unroll
        for (int ai = 0; ai < 2; ++ai)
#pragma unroll
            for (int m = 0; m < 4; ++m) rs[ai][m] = rp[lr + (unsigned)(ai * HALF + m * 16)];
        u32x4 res[2][4][2];
#pragma unroll
        for (int ai = 0; ai < 2; ++ai) {
            u32x4 hv[4][2], pv[4][2];
#pragma unroll
            for (int m = 0; m < 4; ++m)
#pragma unroll
                for (int bj = 0; bj < 2; ++bj) { const unsigned o = (lr + (unsigned)(ai * HALF + m * 16)) * (unsigned)D + cw + (unsigned)(bj * HALF); hv[m][bj] = *(const u32x4*)(hp + o); pv[m][bj] = *(const u32x4*)(pp + o); }
#pragma unroll
            for (int m = 0; m < 4; ++m) { float ssq = 0.f; const float r = rs[ai][m];
#pragma unroll
                for (int bj = 0; bj < 2; ++bj) { const unsigned o = (lr + (unsigned)(ai * HALF + m * 16)) * (unsigned)D + cw + (unsigned)(bj * HALF);
                    float x[8], pj[8]; unpack8(hv[m][bj], x); unpack8(pv[m][bj], pj); const f32x4 v0 = acc[ai][bj][m][0] * r, v1 = acc[ai][bj][m][1] * r;
#pragma unroll
                    for (int j = 0; j < 4; ++j) { x[j] += frcp(1.0f + fexp2(-v0[j] * LOG2E)) * pj[j]; x[4 + j] += frcp(1.0f + fexp2(-v1[j] * LOG2E)) * pj[4 + j]; }
                    if (final) { *(f32x4*)(fp + o) = (f32x4){x[0], x[1], x[2], x[3]}; *(f32x4*)(fp + o + 4) = (f32x4){x[4], x[5], x[6], x[7]}; }
                    else { const u32x4 w = pack8(x); res[ai][m][bj] = w; float y[8]; unpack8(w, y);
                        ssq += (y[0] * y[0] + y[1] * y[1]) + (y[2] * y[2] + y[3] * y[3]) + (y[4] * y[4] + y[5] * y[5]) + (y[6] * y[6] + y[7] * y[7]); } }
                if (!final) { ssq += xshfl<16>(ssq); ssq = sum32x(ssq); if (fq == 0) part[(lr + (unsigned)(ai * HALF + m * 16)) * 16u + (unsigned)(u.pn * 4 + wc)] = ssq; } }
        }
        if (!final) {
#pragma unroll
            for (int ai = 0; ai < 2; ++ai)
#pragma unroll
                for (int m = 0; m < 4; ++m)
#pragma unroll
                    for (int bj = 0; bj < 2; ++bj) { const unsigned o = (lr + (unsigned)(ai * HALF + m * 16)) * (unsigned)D + cw + (unsigned)(bj * HALF); *(u32x4*)(op + o) = res[ai][m][bj];
                        if (hn8) { float y[8]; unpack8(res[ai][m][bj], y); *(u32x2*)(hn8 + ub + o) = pack8_fp8(y); } }
        }
    }
};
#undef EPI_LANE
}

#define XB_TMO      128
#define XB_XCNT(j)  (256  + 64 * (j))
#define XB_XSUB(j)  (1280 + 64 * (j))
#define XB_XGEN(j)  (2304 + 64 * (j))
#define XB_TOP      3328
#define XB_TOPGEN   3392
#define XCD_BAR_WORDS 3456
#define XB_SPIN_CAP (1u << 20)
__device__ __forceinline__ unsigned xb_ld(unsigned* p)              { return __hip_atomic_load(p, __ATOMIC_RELAXED, __HIP_MEMORY_SCOPE_AGENT); }
__device__ __forceinline__ unsigned xb_add(unsigned* p, unsigned v) { return __hip_atomic_fetch_add(p, v, __ATOMIC_RELAXED, __HIP_MEMORY_SCOPE_AGENT); }
__device__ __forceinline__ unsigned xb_xcc_id() { return (unsigned)__builtin_amdgcn_s_getreg((3 << 11) | 20) & 0xFu; }
#define XB_SPIN(cond, bar) do { unsigned _sp = 0; while (cond) { __builtin_amdgcn_s_sleep(1); \
    if ((++_sp & 255u) == 0u) { if (xb_ld(&(bar)[XB_TMO])) break; if (_sp > XB_SPIN_CAP) { atomicAdd(&(bar)[XB_TMO], 1u); break; } } } } while (0)
struct XcdBarrier { unsigned* bar; unsigned x; volatile LAS unsigned* st; };
__device__ __forceinline__ XcdBarrier xcd_barrier_post(unsigned* bar, volatile LAS unsigned* st) {
    XcdBarrier b; b.bar = bar; b.x = xb_xcc_id(); b.st = st;
    if (threadIdx.x == 0) (void)xb_add(&bar[XB_XCNT(b.x)], 1u);
    return b;
}
__device__ __forceinline__ void xcd_barrier_complete(unsigned* bar, unsigned x, unsigned& nloc, unsigned& nx) {
    const unsigned G = gridDim.x * gridDim.y * gridDim.z;
    unsigned sum, cnt, mine, sp = 0u;
    for (;;) {
        sum = 0u; cnt = 0u; mine = 0u;
#pragma unroll
        for (unsigned j = 0; j < 16; ++j) { const unsigned c = xb_ld(&bar[XB_XCNT(j)]); sum += c; cnt += (c > 0u) ? 1u : 0u; mine = (j == x) ? c : mine; }
        if (sum == G) break;
        __builtin_amdgcn_s_sleep(1);
        if ((++sp & 255u) == 0u) { if (xb_ld(&bar[XB_TMO])) break; if (sp > XB_SPIN_CAP) { atomicAdd(&bar[XB_TMO], 1u); break; } }
    }
    nloc = mine > 0u ? mine : 1u; nx = cnt > 0u ? cnt : 1u;
}
__device__ __forceinline__ void xcd_barrier(const XcdBarrier& b, const int wave) {
    asm volatile("s_waitcnt vmcnt(0)" ::: "memory");
    __syncthreads();
    if (wave == 0 && lane_id() == 0) {
        unsigned* bar = b.bar;
        __builtin_amdgcn_s_waitcnt(0);
        unsigned nloc = b.st[0], nx = b.st[1];
        if (nloc == 0u) { xcd_barrier_complete(bar, b.x, nloc, nx); b.st[0] = nloc; b.st[1] = nx; }
        const unsigned old = xb_add(&bar[XB_XSUB(b.x)], 1u);
        const unsigned gen = old / nloc;
        if (old + 1u == (gen + 1u) * nloc) {
            __builtin_amdgcn_fence(__ATOMIC_RELEASE, "agent");
            asm volatile("s_waitcnt vmcnt(0)" ::: "memory");
            const unsigned og = xb_add(&bar[XB_TOP], 1u);
            const unsigned tg = og / nx;
            if (og + 1u == (tg + 1u) * nx) xb_add(&bar[XB_TOPGEN], 1u);
            else XB_SPIN(xb_ld(&bar[XB_TOPGEN]) == tg, bar);
            __builtin_amdgcn_fence(__ATOMIC_ACQUIRE, "agent");
            xb_add(&bar[XB_XGEN(b.x)], 1u);
            asm volatile("s_waitcnt vmcnt(0)" ::: "memory");
        } else {
            XB_SPIN(xb_ld(&bar[XB_XGEN(b.x)]) == gen, bar);
            __builtin_amdgcn_fence(__ATOMIC_ACQUIRE, "agent");
            asm volatile("s_waitcnt vmcnt(0)" ::: "memory");
        }
    }
    __syncthreads();
}

typedef const float* cfp_t;
typedef const __attribute__((address_space(4))) cfp_t* kin_t;
#define GIN(tab, i) ((const float*)(const GAS float*)(tab)[(i)])
struct Args { const float* in[24]; float* out; unsigned char* ws; int ph_lo, ph_hi; };
struct Frame {
    LAS unsigned char* lds;
    int tid, lane, wave, vcu, G;
    kin_t in; float* out; unsigned char* ws;
};
enum { IN_X = 0, IN_P, IN_NMIX, IN_NFFN, IN_WOUT, IN_ROUTER, IN_EG, IN_EU, IN_ED, IN_PLEN, IN_PLEG, IN_PLEP, IN_AWIN, IN_AVN, IN_AWS, IN_ABS, IN_BWIN, IN_BQN, IN_BKN, IN_BSINK, IN_CWIN, IN_CQN, IN_CKN, IN_CRPB };

__device__ __forceinline__ void transpose_item(const float* W, int K, int N, bf16* WT, int k0, int n0, int drow0, LAS float* scr, int lane, const float* gk, int fp8) {
    const int l16 = lane & 15, l4 = lane >> 4;
#pragma unroll 4
    for (int i = 0; i < 16; ++i) { const int kk = 4 * i + l4; const f32x4 v = *(const f32x4*)(W + (size_t)(k0 + kk) * N + n0 + 4 * l16); LAS float* d = scr + kk * 65 + 4 * l16; d[0] = v[0]; d[1] = v[1]; d[2] = v[2]; d[3] = v[3]; }
    LDS_WAIT(); asm volatile("" ::: "memory");
    if (fp8) {
        const int c = lane & 3; const float wsc = (float)(1 << pg8::FP8_WEXP);
        float g[16];
#pragma unroll
        for (int j = 0; j < 16; ++j) g[j] = gk ? gk[k0 + 16 * c + j] * wsc : wsc;
#pragma unroll
        for (int jj = 0; jj < 4; ++jj) { const int n = (lane >> 2) + 16 * jj; const LAS float* sp = scr + (16 * c) * 65 + n;
            float x0[8], x1[8];
#pragma unroll
            for (int j = 0; j < 8; ++j) { x0[j] = sp[j * 65] * g[j]; x1[j] = sp[(8 + j) * 65] * g[8 + j]; }
            const u32x2 a = pack8_fp8(x0), bq = pack8_fp8(x1); u32x4 o; o.x = a.x; o.y = a.y; o.z = bq.x; o.w = bq.y;
            *(u32x4*)((unsigned char*)WT + (size_t)(drow0 + n) * K + k0 + 16 * c) = o; }
    } else {
        const int c = lane & 7;
        float g[8];
#pragma unroll
        for (int j = 0; j < 8; ++j) g[j] = gk ? gk[k0 + 8 * c + j] : 1.0f;
#pragma unroll
        for (int jj = 0; jj < 8; ++jj) { const int n = (lane >> 3) + 8 * jj; const LAS float* sp = scr + (8 * c) * 65 + n;
            u32x4 o; o.x = pk2(sp[0 * 65] * g[0], sp[1 * 65] * g[1]); o.y = pk2(sp[2 * 65] * g[2], sp[3 * 65] * g[3]); o.z = pk2(sp[4 * 65] * g[4], sp[5 * 65] * g[5]); o.w = pk2(sp[6 * 65] * g[6], sp[7 * 65] * g[7]);
            *(u32x4*)(WT + (size_t)(drow0 + n) * K + k0 + 8 * c) = o; }
    }
    LDS_WAIT(); asm volatile("" ::: "memory");
}
__device__ __forceinline__ void cvt_mats(const Frame& F0, const float* W, int K, int N, int nmat, size_t src_stride, bf16* WT, size_t dst_stride, int mode, const float* gk = nullptr, int fp8 = 0) {
    Frame F = F0; F.lane = opaque_i(lane_id()); F.wave = __builtin_amdgcn_readfirstlane(opaque_i(F0.wave)); F.tid = F.wave * 64 + F.lane;
    LAS float* scr = (LAS float*)(F.lds + F.wave * 16896);
    const int gw = F.vcu * NWAVES + F.wave, NGW = F.G * NWAVES;
    const int nblk = N / 64, per = (K / 64) * nblk, total = nmat * per;
    for (int it = gw; it < total; it += NGW) {
        const int mi = it / per, r = it % per, kb = r / nblk, nb = r % nblk, n0 = 64 * nb;
        const int drow0 = mode == 0 ? n0 : ((n0 >> 7) * 256 + (n0 & 127) + (mode == 2 ? 128 : 0));
        transpose_item(W + (size_t)mi * src_stride, K, N, fp8 ? (bf16*)((unsigned char*)WT + (size_t)mi * dst_stride) : WT + (size_t)mi * dst_stride, 64 * kb, n0, drow0, scr, F.lane, gk, fp8);
    }
}
__device__ __forceinline__ void p_convert(const Frame& F) {
    for (int L = 0; L < DEPTH; ++L) {
        unsigned char* wl = F.ws + WS_W + (size_t)L * WL_STRIDE;
        const int kind = L % 3, j = L / 3;
        const float* gmix = GIN(F.in, IN_NMIX) + (size_t)L * D;
        if (kind == 0) cvt_mats(F, GIN(F.in, IN_AWIN) + (size_t)j * D * 2048, D, 2048, 1, 0, (bf16*)(wl + WL_IN), 0, 0, gmix);
        else if (kind == 1) cvt_mats(F, GIN(F.in, IN_BWIN), D, 1536, 1, 0, (bf16*)(wl + WL_IN), 0, 0, gmix, (FP8_IN_MASK >> L) & 1);
        else cvt_mats(F, GIN(F.in, IN_CWIN), D, 3072, 1, 0, (bf16*)(wl + WL_IN), 0, 0, gmix, (FP8_IN_MASK >> L) & 1);
        cvt_mats(F, GIN(F.in, IN_WOUT) + (size_t)L * D * D, D, D, 1, 0, (bf16*)(wl + WL_OUT), 0, 0);
        cvt_mats(F, GIN(F.in, IN_EG) + (size_t)L * NE * D * FF, D, FF, NE, (size_t)D * FF, (bf16*)(wl + WL_GU), (size_t)2 * FF * D, 1, GIN(F.in, IN_NFFN) + (size_t)L * D, 1);
        cvt_mats(F, GIN(F.in, IN_EU) + (size_t)L * NE * D * FF, D, FF, NE, (size_t)D * FF, (bf16*)(wl + WL_GU), (size_t)2 * FF * D, 2, GIN(F.in, IN_NFFN) + (size_t)L * D, 1);
        cvt_mats(F, GIN(F.in, IN_ED) + (size_t)L * NE * FF * D, FF, D, NE, (size_t)FF * D, (bf16*)(wl + WL_DN), (size_t)D * FF, 0, nullptr, 1);
        cvt_mats(F, GIN(F.in, IN_PLEG) + (size_t)L * D * D, D, D, 1, 0, (bf16*)(wl + WL_PG), 0, 0, GIN(F.in, IN_PLEN) + (size_t)L * D, 1);
        cvt_mats(F, GIN(F.in, IN_PLEP) + (size_t)L * PLE * D, PLE, D, 1, 0, (bf16*)(wl + WL_PP), 0, 0);
    }
    { const float* x = GIN(F.in, IN_X); bf16* hb = (bf16*)F.out; float* rstd1 = (float*)(F.ws + WS_RSTD1); const int lane = F.tid & 63;
      for (int row = F.vcu * NWAVES + F.wave; row < T; row += F.G * NWAVES) {
          const f32x4* xr = (const f32x4*)(x + (size_t)row * D) + lane; u32x2* o8 = (u32x2*)(hb + (size_t)row * D) + lane; float ss = 0.f;
#pragma unroll
          for (int q = 0; q < 4; ++q) { const f32x4 v = xr[64 * q]; u32x2 w; w.x = pk2(v[0], v[1]); w.y = pk2(v[2], v[3]); o8[64 * q] = w;
              const float y0 = bf_lo(w.x), y1 = bf_hi(w.x), y2 = bf_lo(w.y), y3 = bf_hi(w.y); ss += (y0 * y0 + y1 * y1) + (y2 * y2 + y3 * y3); }
          ss = wave_sum(ss); if (lane == 0) rstd1[row] = 1.0f / sqrtf(ss * (1.0f / D) + RMS_EPS); } }
    { const float* src = GIN(F.in, IN_AWS); bf16* dst = (bf16*)(F.ws + WS_WSA); const int n4 = 2 * 8 * 128 * 128 / 4;
      for (int i = F.vcu * NTHREADS + F.tid; i < n4; i += F.G * NTHREADS) { const f32x4 v = *(const f32x4*)(src + 4 * (size_t)i); u32x2 w; w.x = pk2(v[0], v[1]); w.y = pk2(v[2], v[3]); *(u32x2*)(dst + 4 * (size_t)i) = w; } }
}

__device__ __forceinline__ void p_router(const Frame& F0, const bf16* hb, const float* g, const float* rw, float* rstd_out, float* aff, unsigned char* hb8  ) {
    Frame F = F0; F.lane = opaque_i(lane_id()); F.wave = __builtin_amdgcn_readfirstlane(opaque_i(F0.wave)); F.tid = F.wave * 64 + F.lane;
    constexpr int WPITCH = 1032;
    LAS bf16* Whi = (LAS bf16*)F.lds; LAS bf16* Wlo = Whi + 16 * WPITCH;
    for (int i = 0; i < 32; ++i) { const int idx = F.tid + NTHREADS * i, d = idx >> 4, e = idx & 15; const float w = rw[idx] * g[d];
        const bf16 hi = f2bf(w); const bf16 lo = f2bf(w - bf1(hi)); Whi[e * WPITCH + d] = hi; Wlo[e * WPITCH + d] = lo; }
    __syncthreads();
    const int gw = F.vcu * NWAVES + F.wave, NGW = F.G * NWAVES;
    const int fr = F.lane & 15, fq = F.lane >> 4;
    for (int tile = gw; tile < T / 16; tile += NGW) {
        const size_t row = (size_t)tile * 16 + fr;
        const bf16* hp = hb + row * D + 8 * fq; unsigned char* h8 = hb8 + row * D + 8 * fq;
        f32x4 acc = {0.f, 0.f, 0.f, 0.f}; float ss = 0.f;
#pragma unroll 1
        for (int sb = 0; sb < 2; ++sb) {
            u32x4 v[16];
#pragma unroll
            for (int s = 0; s < 16; ++s) v[s] = *(const u32x4*)(hp + 32 * (16 * sb + s));
#pragma unroll
            for (int s = 0; s < 16; ++s) { const u32x4 w = v[s];
                const float x0 = bf_lo(w.x), x1 = bf_hi(w.x), x2 = bf_lo(w.y), x3 = bf_hi(w.y), x4 = bf_lo(w.z), x5 = bf_hi(w.z), x6 = bf_lo(w.w), x7 = bf_hi(w.w);
                ss += (x0 * x0 + x1 * x1) + (x2 * x2 + x3 * x3) + (x4 * x4 + x5 * x5) + (x6 * x6 + x7 * x7);
                { const float xx[8] = {x0, x1, x2, x3, x4, x5, x6, x7}; *(u32x2*)(h8 + 32 * (16 * sb + s)) = pack8_fp8(xx); }
                const bf16x8 whi = *(const LAS bf16x8*)(Whi + fr * WPITCH + 32 * (16 * sb + s) + 8 * fq), wlo = *(const LAS bf16x8*)(Wlo + fr * WPITCH + 32 * (16 * sb + s) + 8 * fq);
                const bf16x8 hh = __builtin_bit_cast(bf16x8, w);
                acc = __builtin_amdgcn_mfma_f32_16x16x32_bf16(whi, hh, acc, 0, 0, 0);
                acc = __builtin_amdgcn_mfma_f32_16x16x32_bf16(wlo, hh, acc, 0, 0, 0); }
        }
        ss += xshfl<16>(ss); ss = sum32x(ss);
        const float rstd = 1.0f / sqrtf(ss * (1.0f / D) + RMS_EPS);
        f32x4 l = acc * rstd;
        float mx = fmaxf(fmaxf(l[0], l[1]), fmaxf(l[2], l[3])); mx = fmaxf(mx, xshfl<16>(mx)); mx = max32x(mx);
        f32x4 ev; ev[0] = __expf(l[0] - mx); ev[1] = __expf(l[1] - mx); ev[2] = __expf(l[2] - mx); ev[3] = __expf(l[3] - mx);
        float se = (ev[0] + ev[1]) + (ev[2] + ev[3]); se += xshfl<16>(se); se = sum32x(se);
        *(f32x4*)(aff + row * 16 + 4 * fq) = ev * (1.0f / se);
        if (fq == 0) rstd_out[row] = rstd;
    }
    __syncthreads();
}
__device__ __forceinline__ void p_topk(const Frame& F0, const float* aff, const float* rstd, int* idx, float* gatev, float* rsel, int* slot) {
    Frame F = F0; F.lane = opaque_i(lane_id()); F.wave = __builtin_amdgcn_readfirstlane(opaque_i(F0.wave)); F.tid = F.wave * 64 + F.lane;
    LAS unsigned* hist = (LAS unsigned*)F.lds;
    LAS unsigned* sh = hist + 256;
    for (int u = blockIdx.x; u < NBATCH * NE; u += F.G) {
        const int b = u >> 4, e = u & 15;
        unsigned key[4];
        const float* ap = aff + ((size_t)b * SEQ + F.tid * 4) * 16 + e;
#pragma unroll
        for (int j = 0; j < 4; ++j) key[j] = __float_as_uint(ap[j * 16]);
        unsigned prefix = 0, need = CAP;
        for (int pass = 0; pass < 4; ++pass) {
            const int shift = 24 - 8 * pass;
            if (F.tid < 256) hist[F.tid] = 0;
            __syncthreads();
#pragma unroll
            for (int j = 0; j < 4; ++j) { const bool match = (pass == 0) || ((key[j] >> ((shift + 8) & 31)) == prefix); if (match) __hip_atomic_fetch_add(&hist[(key[j] >> shift) & 255u], 1u, __ATOMIC_RELAXED, __HIP_MEMORY_SCOPE_WORKGROUP); }
            __syncthreads();
            if (F.wave == 0) {
                const u32x4 h4 = *(const LAS u32x4*)(hist + 4 * F.lane); const unsigned own = (h4.x + h4.y) + (h4.z + h4.w); unsigned suf = own;
#pragma unroll
                for (int o = 1; o < 64; o <<= 1) { const unsigned t = (unsigned)__builtin_amdgcn_ds_bpermute(((F.lane + o) & 63) * 4, (int)suf); if (F.lane + o < 64) suf += t; }
                unsigned above = suf - own;
                if (above < need && suf >= need) {
                    unsigned dsel = 0, nn = 0; const unsigned hb[4] = {h4.x, h4.y, h4.z, h4.w};
#pragma unroll
                    for (int q = 3; q >= 0; --q) { if (above < need && above + hb[q] >= need) { dsel = (unsigned)(4 * F.lane + q); nn = need - above; } above += hb[q]; }
                    sh[0] = (prefix << 8) | dsel; sh[1] = nn; } }
            __syncthreads();
            prefix = sh[0]; need = sh[1];
            __syncthreads();
        }
        unsigned cg = 0, ce = 0;
#pragma unroll
        for (int j = 0; j < 4; ++j) { cg += key[j] > prefix ? 1u : 0u; ce += key[j] == prefix ? 1u : 0u; }
        const unsigned v = cg | (ce << 16); unsigned inc = v;
#pragma unroll
        for (int o = 1; o < 64; o <<= 1) { const unsigned t = (unsigned)__builtin_amdgcn_ds_bpermute(((F.lane - o) & 63) * 4, (int)inc); if (F.lane >= o) inc += t; }
        if (F.lane == 63) sh[8 + F.wave] = inc;
        __syncthreads();
        unsigned base = 0;
        for (int w = 0; w < F.wave; ++w) base += sh[8 + w];
        const unsigned exc = base + inc - v;
        unsigned pg = exc & 0xffffu, pe = exc >> 16;
#pragma unroll
        for (int j = 0; j < 4; ++j) {
            const int s = F.tid * 4 + j; int c = -1;
            if (key[j] > prefix) { c = (int)(pg + (pe < need ? pe : need)); pg++; }
            else if (key[j] == prefix) { if (pe < need) c = (int)(pg + pe); pe++; }
            if (c >= 0) { idx[u * CAP + c] = s; gatev[u * CAP + c] = __uint_as_float(key[j]); rsel[u * CAP + c] = rstd[(size_t)b * SEQ + s]; }
            slot[((size_t)b * SEQ + s) * 16 + e] = c;
        }
        __syncthreads();
    }
}
__device__ __forceinline__ void p_combine(const Frame& F0, const bf16* Hin, bf16* Hout, const unsigned char* y, const int* slot, float* rstd3, const float* p, bf16* pb, unsigned char* h8) {
    Frame F = F0; F.lane = opaque_i(lane_id()); F.wave = __builtin_amdgcn_readfirstlane(opaque_i(F0.wave)); F.tid = F.wave * 64 + F.lane;
    for (int pm = (int)blockIdx.x; pm < T / 256; pm += F.G) {
        const int row0 = pm * 256 + F.wave * 32, b = row0 >> 11;
        const unsigned char* yb = y + (size_t)b * NE * CAP * D;
        u32x4 nh0, nh1; f32x4 npv; int nsl;
        { const u32x4* hr = (const u32x4*)(Hin + (size_t)row0 * D) + F.lane; nh0 = hr[0]; nh1 = hr[64]; nsl = slot[(size_t)row0 * 16 + (F.lane & 15)]; npv = *((const f32x4*)(p + (size_t)row0 * PLE) + F.lane); }
#pragma unroll 1
        for (int rr = 0; rr < 32; ++rr) {
            const int row = row0 + rr;
            const u32x4 w0 = nh0, w1 = nh1; const f32x4 pv = npv; const int sl = nsl;
            if (rr < 31) { const u32x4* hr = (const u32x4*)(Hin + (size_t)(row + 1) * D) + F.lane; nh0 = hr[0]; nh1 = hr[64]; nsl = slot[(size_t)(row + 1) * 16 + (F.lane & 15)]; npv = *((const f32x4*)(p + (size_t)(row + 1) * PLE) + F.lane); }
            float v[2][8]; pg8::unpack8(w0, v[0]); pg8::unpack8(w1, v[1]);
            unsigned m = (unsigned)__builtin_amdgcn_ballot_w64(sl >= 0) & 0xffffu;
            while (m) {
                const int e0 = __builtin_ctz(m); m &= m - 1u; const bool two = m != 0u; const int e1 = two ? __builtin_ctz(m) : e0; if (two) m &= m - 1u;
                const int c0 = __builtin_amdgcn_readlane(sl, e0), c1 = __builtin_amdgcn_readlane(sl, e1);
                const u32x2* y0 = (const u32x2*)(yb + ((size_t)(e0 * CAP + c0)) * D) + F.lane; const u32x2* y1 = (const u32x2*)(yb + ((size_t)(e1 * CAP + c1)) * D) + F.lane;
                const u32x2 a0 = y0[0], a1 = y0[64], b0 = y1[0], b1 = y1[64];
                float t0[8], t1[8]; unpack8_fp8(a0, t0); unpack8_fp8(a1, t1);
#pragma unroll
                for (int q = 0; q < 8; ++q) { v[0][q] += t0[q]; v[1][q] += t1[q]; }
                if (two) { unpack8_fp8(b0, t0); unpack8_fp8(b1, t1);
#pragma unroll
                    for (int q = 0; q < 8; ++q) { v[0][q] += t0[q]; v[1][q] += t1[q]; } }
            }
            const u32x4 o0 = pg8::pack8(v[0]), o1 = pg8::pack8(v[1]);
            u32x4* orow = (u32x4*)(Hout + (size_t)row * D) + F.lane; orow[0] = o0; orow[64] = o1;
            float y0f[8], y1f[8]; pg8::unpack8(o0, y0f); pg8::unpack8(o1, y1f); float ss = 0.f;
#pragma unroll
            for (int q = 0; q < 8; ++q) ss += y0f[q] * y0f[q] + y1f[q] * y1f[q];
            u32x2* r8 = (u32x2*)(h8 + (size_t)row * D) + F.lane; r8[0] = pack8_fp8(y0f); r8[64] = pack8_fp8(y1f);
            ss = wave_sum(ss); if (F.lane == 0) rstd3[row] = 1.0f / sqrtf(ss * (1.0f / D) + RMS_EPS);
            u32x2 pw; pw.x = pk2(pv[0], pv[1]); pw.y = pk2(pv[2], pv[3]);
            *((u32x2*)(pb + (size_t)row * PLE) + F.lane) = pw;
        }
    }
}

__device__ __forceinline__ void p_mix_a(const Frame& F0, const bf16* z, const float* gamma, const bf16* wsb  , const float* bs  , bf16* mix, const float* vst  ) {
    Frame F = F0; F.lane = opaque_i(lane_id()); F.wave = __builtin_amdgcn_readfirstlane(opaque_i(F0.wave)); F.tid = F.wave * 64 + F.lane;
    constexpr int WP = 136, OP = 132;
    LAS float* mu = (LAS float*)F.lds; LAS float* rs = mu + 128;
    LAS bf16* WS = (LAS bf16*)(F.lds + 1024);
    LAS bf16* VN = WS + 128 * WP;
    LAS float* OUT = (LAS float*)(VN + 128 * 128);
    const int r = F.lane & 31, hh = F.lane >> 5, i16 = F.lane & 15, g16 = (F.lane >> 4) & 1;
    for (int u = blockIdx.x; u < T / 128; u += F.G) {
        const size_t tok0 = (size_t)u * 128;
        if (F.tid < 128) { const f32x4* sp = (const f32x4*)(vst + (tok0 + F.tid) * 32); float s1 = 0.f, s2 = 0.f;
#pragma unroll
            for (int q = 0; q < 8; ++q) { const f32x4 t = sp[q]; s1 += t[0]; s2 += t[1]; s1 += t[2]; s2 += t[3]; }
            const float mean = s1 * (1.0f / 1024.0f); const float var = fmaxf(s2 * (1.0f / 1024.0f) - mean * mean, 0.f);
            mu[F.tid] = mean; rs[F.tid] = 1.0f / sqrtf(var + LN_EPS); }
        const int srow = F.tid >> 4, sch = F.tid & 15;
        const bf16* zt = z + tok0 * 2048; bf16* mt = mix + tok0 * D;
        u32x4 wreg[4], vreg[4], ureg[4], unext[4];
#pragma unroll
        for (int i = 0; i < 4; ++i) { wreg[i] = *(const u32x4*)(wsb + (size_t)(srow + 32 * i) * 128 + sch * 8); vreg[i] = *(const u32x4*)(zt + (size_t)(srow + 32 * i) * 2048 + 1024 + sch * 8); ureg[i] = *(const u32x4*)(zt + (size_t)(srow + 32 * i) * 2048 + sch * 8); unext[i] = ureg[i]; }
        __syncthreads();
#pragma unroll 1
        for (int g = 0; g < 8; ++g) {
            { const f32x4 g0 = *(const f32x4*)(gamma + g * 128 + sch * 8), g1 = *(const f32x4*)(gamma + g * 128 + sch * 8 + 4);
#pragma unroll
              for (int i = 0; i < 4; ++i) { const int row = srow + 32 * i;
                  *(LAS u32x4*)(WS + row * WP + sch * 8) = wreg[i];
                  float x[8]; pg8::unpack8(vreg[i], x); const float m = mu[row], rr = rs[row];
                  x[0] = (x[0] - m) * rr * g0[0]; x[1] = (x[1] - m) * rr * g0[1]; x[2] = (x[2] - m) * rr * g0[2]; x[3] = (x[3] - m) * rr * g0[3];
                  x[4] = (x[4] - m) * rr * g1[0]; x[5] = (x[5] - m) * rr * g1[1]; x[6] = (x[6] - m) * rr * g1[2]; x[7] = (x[7] - m) * rr * g1[3];
                  *(LAS u32x4*)(VN + row * 128 + ((sch ^ ((row & 3) << 2)) * 8)) = pg8::pack8(x); } }
            __syncthreads();
#pragma unroll
            for (int i = 0; i < 4; ++i) {
                if (g < 7) { unext[i] = *(const u32x4*)(zt + (size_t)(srow + 32 * i) * 2048 + (g + 1) * 128 + sch * 8); wreg[i] = *(const u32x4*)(wsb + ((size_t)(g + 1) * 128 + srow + 32 * i) * 128 + sch * 8); vreg[i] = *(const u32x4*)(zt + (size_t)(srow + 32 * i) * 2048 + 1024 + (g + 1) * 128 + sch * 8); } }
            const int t0 = 32 * (F.wave >> 1), c0 = 64 * (F.wave & 1);
            f32x16 acc[2];
#pragma unroll
            for (int ct = 0; ct < 2; ++ct)
#pragma unroll
                for (int i = 0; i < 16; ++i) acc[ct][i] = 0.f;
#pragma unroll
            for (int ks = 0; ks < 8; ++ks) {
                const bf16x8 a = *(const LAS bf16x8*)(WS + (t0 + r) * WP + 16 * ks + 8 * hh);
                const int s0 = 16 * ks + 8 * hh + (i16 >> 2), s1 = s0 + 4;
#pragma unroll
                for (int ct = 0; ct < 2; ++ct) { const int chunk = (c0 + 32 * ct + 16 * g16) / 8 + ((i16 & 3) >> 1), h8 = 4 * (i16 & 1);
                    const s16x4 lo = __builtin_amdgcn_ds_read_tr16_b64_v4i16((LAS s16x4*)(VN + s0 * 128 + ((chunk ^ ((s0 & 3) << 2)) * 8) + h8));
                    const s16x4 hi = __builtin_amdgcn_ds_read_tr16_b64_v4i16((LAS s16x4*)(VN + s1 * 128 + ((chunk ^ ((s1 & 3) << 2)) * 8) + h8));
                    const bf16x8 bv = __builtin_shufflevector(lo, hi, 0, 1, 2, 3, 4, 5, 6, 7);
                    acc[ct] = __builtin_amdgcn_mfma_f32_32x32x16_bf16(a, bv, acc[ct], 0, 0, 0); }
            }
#pragma unroll
            for (int ct = 0; ct < 2; ++ct)
#pragma unroll
                for (int i = 0; i < 16; ++i) OUT[(t0 + (i & 3) + 8 * (i >> 2) + 4 * hh) * OP + c0 + 32 * ct + r] = acc[ct][i];
            __syncthreads();
#pragma unroll
            for (int i = 0; i < 4; ++i) { const int row = srow + 32 * i; const LAS f32x4* op = (const LAS f32x4*)(OUT + row * OP + sch * 8); const f32x4 s0v = op[0], s1v = op[1]; const float bb = bs[g * 128 + row];
                float uu[8]; pg8::unpack8(ureg[i], uu);
                uu[0] *= s0v[0] + bb; uu[1] *= s0v[1] + bb; uu[2] *= s0v[2] + bb; uu[3] *= s0v[3] + bb; uu[4] *= s1v[0] + bb; uu[5] *= s1v[1] + bb; uu[6] *= s1v[2] + bb; uu[7] *= s1v[3] + bb;
                *(u32x4*)(mt + (size_t)row * D + g * 128 + sch * 8) = pg8::pack8(uu); }
#pragma unroll
            for (int i = 0; i < 4; ++i) ureg[i] = unext[i];
        }
        __syncthreads();
    }
}

template <bool ON0, bool ON1>
__device__ __forceinline__ void mixb_tile(const int j, const LAS bf16* KS, const LAS bf16* VS, const int KP, const bf16x8 (&Qf)[2][4], f32x16 (&O)[2][2], const float (&mrun)[2], float (&lrun)[2],
                                          const int t0, const int qh, const int r, const int hh, const int i16, const int g16, const float slope2) {
    const int kt = 2 * qh + j, kb0 = 32 * kt;
    if (t0 - 128 + kb0 < 0 || t0 - 128 + kb0 >= SEQ) return;
    const int dlt0 = 32 * j - 128, dlt1 = dlt0 - 32;
    f32x16 S[2];
    bf16x8 vf[2][2];
    { f32x16 zero16;
#pragma unroll
      for (int i = 0; i < 16; ++i) zero16[i] = 0.f;
      S[0] = zero16; S[1] = zero16;
      bf16x8 kf[4];
#pragma unroll
      for (int s4 = 0; s4 < 4; ++s4) kf[s4] = *(const LAS bf16x8*)(KS + (kb0 + r) * KP + 16 * s4 + 8 * hh);
      if (ON0) {
#pragma unroll
          for (int s4 = 0; s4 < 4; ++s4) S[0] = __builtin_amdgcn_mfma_f32_32x32x16_bf16(kf[s4], Qf[0][s4], s4 ? S[0] : zero16, 0, 0, 0); }
      if (ON1) {
#pragma unroll
          for (int s4 = 0; s4 < 4; ++s4) S[1] = __builtin_amdgcn_mfma_f32_32x32x16_bf16(kf[s4], Qf[1][s4], s4 ? S[1] : zero16, 0, 0, 0); } }
#pragma unroll
    for (int s2 = 0; s2 < 2; ++s2) {
        const int k0 = kb0 + 16 * s2 + 4 * hh + (i16 >> 2), k1 = k0 + 8;
        const int sw0 = ((k0 >> 1) & 1) << 2, sw1 = ((k1 >> 1) & 1) << 2;
#pragma unroll
        for (int dt = 0; dt < 2; ++dt) { const int chunk = 4 * dt + 2 * g16 + ((i16 & 3) >> 1), h8 = 4 * (i16 & 1);
            const s16x4 lo = __builtin_amdgcn_ds_read_tr16_b64_v4i16((LAS s16x4*)(VS + k0 * 64 + ((chunk ^ sw0) * 8) + h8));
            const s16x4 hi = __builtin_amdgcn_ds_read_tr16_b64_v4i16((LAS s16x4*)(VS + k1 * 64 + ((chunk ^ sw1) * 8) + h8));
            vf[s2][dt] = __builtin_shufflevector(lo, hi, 0, 1, 2, 3, 4, 5, 6, 7); } }
#pragma unroll
    for (int qb = 0; qb < 2; ++qb) {
        const int dlt = qb ? dlt1 : dlt0; const bool on = qb ? ON1 : ON0;
        if (on) {
            const float d0 = (float)(dlt + 4 * hh - r);
            float a0 = 0.f;
            if (dlt != 0 && dlt >= -96 && dlt <= 96) {
                const float ss = dlt > 0 ? slope2 : -slope2; a0 = ss * d0;
#pragma unroll
                for (int i = 0; i < 16; ++i) S[qb][i] += ss * (float)((i & 3) + 8 * (i >> 2));
            } else if (dlt == 0) {
#pragma unroll
                for (int i = 0; i < 16; ++i) { const float rel = d0 + (float)((i & 3) + 8 * (i >> 2)); S[qb][i] += slope2 * fabsf(rel); }
            } else {
                asm volatile("" ::: "memory");
#pragma unroll
                for (int i = 0; i < 16; ++i) { const float rel = d0 + (float)((i & 3) + 8 * (i >> 2)); const float ar = fabsf(rel); S[qb][i] = ar <= 128.0f ? S[qb][i] + slope2 * ar : -1e30f; }
            }
            float ls = 0.f; const float mm = mrun[qb] - a0;
#pragma unroll
            for (int i = 0; i < 16; ++i) { const float pv = fexp2(S[qb][i] - mm); S[qb][i] = pv; ls += pv; }
            lrun[qb] += ls;
        }
    }
#pragma unroll
    for (int s2 = 0; s2 < 2; ++s2) {
        bf16x8 Pf[2];
#pragma unroll
        for (int qb = 0; qb < 2; ++qb) { u32x4 o; o.x = pk2(S[qb][8 * s2 + 0], S[qb][8 * s2 + 1]); o.y = pk2(S[qb][8 * s2 + 2], S[qb][8 * s2 + 3]); o.z = pk2(S[qb][8 * s2 + 4], S[qb][8 * s2 + 5]); o.w = pk2(S[qb][8 * s2 + 6], S[qb][8 * s2 + 7]);
            Pf[qb] = __builtin_bit_cast(bf16x8, o); }
#pragma unroll
        for (int dt = 0; dt < 2; ++dt) {
            if (ON0) O[0][dt] = __builtin_amdgcn_mfma_f32_32x32x16_bf16(vf[s2][dt], Pf[0], O[0][dt], 0, 0, 0);
            if (ON1) O[1][dt] = __builtin_amdgcn_mfma_f32_32x32x16_bf16(vf[s2][dt], Pf[1], O[1][dt], 0, 0, 0); }
    }
}
__device__ __forceinline__ void mixb_max(const int j, const LAS bf16* KS, const int KP, const bf16x8 (&Qf)[2][4], float (&mloc)[2], const int t0, const int qh, const int r, const int hh, const float slope2) {
    const int kt = 2 * qh + j, kb0 = 32 * kt;
    if (t0 - 128 + kb0 < 0 || t0 - 128 + kb0 >= SEQ) return;
    bf16x8 kf[4];
#pragma unroll
    for (int s4 = 0; s4 < 4; ++s4) kf[s4] = *(const LAS bf16x8*)(KS + (kb0 + r) * KP + 16 * s4 + 8 * hh);
#pragma unroll
    for (int qb = 0; qb < 2; ++qb) { const int dlt = 32 * j - 128 - 32 * qb;
        if (dlt > -160 && dlt < 160) {
            f32x16 S;
#pragma unroll
            for (int i = 0; i < 16; ++i) S[i] = 0.f;
#pragma unroll
            for (int s4 = 0; s4 < 4; ++s4) S = __builtin_amdgcn_mfma_f32_32x32x16_bf16(kf[s4], Qf[qb][s4], S, 0, 0, 0);
            const float d0 = (float)(dlt + 4 * hh - r); float m = qb ? mloc[1] : mloc[0];
#pragma unroll
            for (int i = 0; i < 16; ++i) { const float ar = fabsf(d0 + (float)((i & 3) + 8 * (i >> 2))); m = fmaxf(m, ar <= 128.0f ? S[i] + slope2 * ar : -1e30f); }
            if (qb) mloc[1] = m; else mloc[0] = m; } }
}
__device__ __forceinline__ void p_mix_b(const Frame& F0, const bf16* z, const float* qn_g, const float* kn_g, const float* sink, bf16* mix) {
    Frame F = F0; F.lane = opaque_i(lane_id()); F.wave = __builtin_amdgcn_readfirstlane(opaque_i(F0.wave)); F.tid = F.wave * 64 + F.lane;
    constexpr int KP = 72;
    LAS bf16* KS0 = (LAS bf16*)F.lds; LAS bf16* VS0 = KS0 + 512 * KP;
    const int r = F.lane & 31, hh = F.lane >> 5, i16 = F.lane & 15, g16 = (F.lane >> 4) & 1;
    const int g = F.wave >> 1, qh = F.wave & 1;
    volatile LAS float* sbl = (volatile LAS float*)(F.lds + 139264 + 64);
    sbl[0] = wave_max(fabsf(qn_g[F.lane])) * wave_max(fabsf(kn_g[F.lane])) * (8.0f * LOG2E * 1.02f);
    for (int u = F.vcu; u < NBATCH * 4 * 8; u += F.G) {
        const int b = u >> 5, kvh = (u >> 3) & 3, nb = u & 7, t00 = nb * 256;
        const size_t tokb = (size_t)b * SEQ;
#pragma unroll 4
        for (int i = 0; i < 8; ++i) { const int q = F.tid + NTHREADS * i, row = q >> 3, ch = q & 7; const int kpos = t00 - 128 + row; const bool valid = kpos >= 0 && kpos < SEQ;
            u32x4 kw = {0u, 0u, 0u, 0u}, vw = {0u, 0u, 0u, 0u};
            if (valid) { const bf16* zr = z + (tokb + kpos) * 1536 + 1024 + kvh * 64 + ch * 8; kw = *(const u32x4*)zr; vw = *(const u32x4*)(zr + 256); }
            float x[8]; pg8::unpack8(kw, x);
            float ss = 0.f;
#pragma unroll
            for (int j = 0; j < 8; ++j) ss += x[j] * x[j];
            ss += xshfl<1>(ss); ss += xshfl<2>(ss); ss += xshfl<4>(ss);
            const float rstd = 1.0f / sqrtf(ss * (1.0f / 64.0f) + RMS_EPS);
            const f32x4 g0 = *(const f32x4*)(kn_g + ch * 8), g1 = *(const f32x4*)(kn_g + ch * 8 + 4);
            u32x4 o; o.x = pk2(x[0] * rstd * g0[0], x[1] * rstd * g0[1]); o.y = pk2(x[2] * rstd * g0[2], x[3] * rstd * g0[3]); o.z = pk2(x[4] * rstd * g1[0], x[5] * rstd * g1[1]); o.w = pk2(x[6] * rstd * g1[2], x[7] * rstd * g1[3]);
            *(LAS u32x4*)(KS0 + row * KP + ch * 8) = o;
            *(LAS u32x4*)(VS0 + row * 64 + ((ch ^ (((row >> 1) & 1) << 2)) * 8)) = vw; }
        __syncthreads();
#pragma unroll 1
        for (int half = 0; half < 2; ++half) {
        const int t0 = t00 + 128 * half; const LAS bf16* KS = KS0 + 128 * half * KP; const LAS bf16* VS = VS0 + 128 * half * 64;
        const int head = kvh * 4 + g;
        bf16x8 Qf[2][4];
        {
            const float qscale = 0.125f * LOG2E;
#pragma unroll
            for (int qb = 0; qb < 2; ++qb) { const int tq = t0 + 64 * qh + 32 * qb + r; const bf16* zr = z + (tokb + tq) * 1536 + head * 64 + 8 * hh;
                float x[32]; float ss = 0.f;
#pragma unroll
                for (int s4 = 0; s4 < 4; ++s4) { const u32x4 w = *(const u32x4*)(zr + 16 * s4);
                    x[8 * s4 + 0] = bf_lo(w.x); x[8 * s4 + 1] = bf_hi(w.x); x[8 * s4 + 2] = bf_lo(w.y); x[8 * s4 + 3] = bf_hi(w.y); x[8 * s4 + 4] = bf_lo(w.z); x[8 * s4 + 5] = bf_hi(w.z); x[8 * s4 + 6] = bf_lo(w.w); x[8 * s4 + 7] = bf_hi(w.w); }
#pragma unroll
                for (int j = 0; j < 32; ++j) ss += x[j] * x[j];
                ss = sum32x(ss);
                const float rstd = qscale / sqrtf(ss * (1.0f / 64.0f) + RMS_EPS);
#pragma unroll
                for (int s4 = 0; s4 < 4; ++s4) { const f32x4 g0 = *(const f32x4*)(qn_g + 16 * s4 + 8 * hh), g1 = *(const f32x4*)(qn_g + 16 * s4 + 8 * hh + 4);
                    u32x4 o; o.x = pk2(x[8 * s4 + 0] * rstd * g0[0], x[8 * s4 + 1] * rstd * g0[1]); o.y = pk2(x[8 * s4 + 2] * rstd * g0[2], x[8 * s4 + 3] * rstd * g0[3]);
                    o.z = pk2(x[8 * s4 + 4] * rstd * g1[0], x[8 * s4 + 5] * rstd * g1[1]); o.w = pk2(x[8 * s4 + 6] * rstd * g1[2], x[8 * s4 + 7] * rstd * g1[3]);
                    Qf[qb][s4] = __builtin_bit_cast(bf16x8, o); } }
        }
        const float slope2 = -exp2f(-0.5f * (float)(head + 1)) * LOG2E;
        const float sk = sink[head] * LOG2E;
        const float sbound = __uint_as_float(__builtin_amdgcn_readfirstlane(__float_as_uint(sbl[0])));
        float mrun[2] = {fmaxf(sbound, sk), fmaxf(sbound, sk)};
#ifndef PROBE_TWOPASS
#define PROBE_TWOPASS 0
#endif
        if (PROBE_TWOPASS || sbound > 48.0f) {
            float mloc[2] = {sk, sk};
#pragma unroll 1
            for (int j = 0; j < 10; ++j) mixb_max(j, KS, KP, Qf, mloc, t0, qh, r, hh, slope2);
            mrun[0] = max32x(mloc[0]); mrun[1] = max32x(mloc[1]);
        }
        float lrun[2] = {hh == 0 ? fexp2(sk - mrun[0]) : 0.0f, hh == 0 ? fexp2(sk - mrun[1]) : 0.0f};
        f32x16 O[2][2];
#pragma unroll
        for (int qb = 0; qb < 2; ++qb)
#pragma unroll
            for (int dt = 0; dt < 2; ++dt)
#pragma unroll
                for (int i = 0; i < 16; ++i) O[qb][dt][i] = 0.f;
#pragma unroll 1
        for (int jj = 0; jj < 8; ++jj) {
            const int j = (jj & 1) ? 5 + (jj >> 1) : 4 - (jj >> 1);
            mixb_tile<true, true>(j, KS, VS, KP, Qf, O, mrun, lrun, t0, qh, r, hh, i16, g16, slope2);
        }
        mixb_tile<true, false>(0, KS, VS, KP, Qf, O, mrun, lrun, t0, qh, r, hh, i16, g16, slope2);
        mixb_tile<false, true>(9, KS, VS, KP, Qf, O, mrun, lrun, t0, qh, r, hh, i16, g16, slope2);
#pragma unroll
        for (int qb = 0; qb < 2; ++qb) { const float lt = sum32x(lrun[qb]); const float inv = 1.0f / lt;
            const int tq = t0 + 64 * qh + 32 * qb + r; bf16* orow = mix + (tokb + tq) * D + head * 64;
#pragma unroll
            for (int dt = 0; dt < 2; ++dt)
#pragma unroll
                for (int gq = 0; gq < 4; ++gq) { u32x2 w; w.x = pk2(O[qb][dt][4 * gq + 0] * inv, O[qb][dt][4 * gq + 1] * inv); w.y = pk2(O[qb][dt][4 * gq + 2] * inv, O[qb][dt][4 * gq + 3] * inv);
                    *(u32x2*)(orow + 32 * dt + 8 * gq + 4 * hh) = w; } }
        }
        __syncthreads();
    }
}

__device__ __forceinline__ void mixc_put(LAS bf16* KS, LAS bf16* VS, const u32x4 kw, const u32x4 vw, int key, int ch, const float* kn_g) {
    float x[8]; pg8::unpack8(kw, x);
    float ss = 0.f;
#pragma unroll
    for (int j = 0; j < 8; ++j) ss += x[j] * x[j];
    ss += xshfl<1>(ss); ss += xshfl<2>(ss); ss += xshfl<4>(ss);
    const float rstd = 1.0f / sqrtf(ss * (1.0f / 64.0f) + RMS_EPS);
    const f32x4 g0 = *(const f32x4*)(kn_g + ch * 8), g1 = *(const f32x4*)(kn_g + ch * 8 + 4);
    u32x4 o; o.x = pk2(x[0] * rstd * g0[0], x[1] * rstd * g0[1]); o.y = pk2(x[2] * rstd * g0[2], x[3] * rstd * g0[3]); o.z = pk2(x[4] * rstd * g1[0], x[5] * rstd * g1[1]); o.w = pk2(x[6] * rstd * g1[2], x[7] * rstd * g1[3]);
    *(LAS u32x4*)(KS + key * 64 + ((ch ^ (key & 7)) * 8)) = o;
    *(LAS u32x4*)(VS + key * 64 + ((ch ^ (((key >> 1) & 3) << 1)) * 8)) = vw;
}
__device__ __forceinline__ void p_mix_c(const Frame& F0, const bf16* z, const float* qn_g, const float* kn_g, const float* rpb, bf16* mix) {
    Frame F = F0; F.lane = opaque_i(lane_id()); F.wave = __builtin_amdgcn_readfirstlane(opaque_i(F0.wave)); F.tid = F.wave * 64 + F.lane;
    constexpr int NK = 576;
    LAS bf16* KS = (LAS bf16*)F.lds; LAS bf16* VS = KS + NK * 64; LAS float* BT = (LAS float*)(VS + NK * 64) + 16;
    const int fr = F.lane & 15, fq = F.lane >> 4;
    const int qr = F.wave >> 2, n = F.wave & 3;
    const int skc = F.tid >> 3, sch = F.tid & 7;
    for (int u = blockIdx.x; u < NBATCH * 16; u += F.G) {
      const int b = u >> 4, head = u & 15;
      const size_t tokb = (size_t)b * SEQ;
      const bf16* zk = z + tokb * 3072 + 1024 + head * 64 + sch * 8;
      const bf16* zq = z + (tokb + (size_t)(16 * n + fr)) * 3072 + head * 64 + 8 * fq;
      if (F.tid < 480) { const int r = F.tid >> 5, c = F.tid & 31; BT[F.tid] = (c < 31) ? rpb[(head * 15 + r) * 31 + c] * LOG2E : 0.f; }
#pragma unroll 2
      for (int row = 0; row < 8; ++row) { const bf16* zr = zk + (size_t)(row * 64 + skc) * 3072; const u32x4 kw = *(const u32x4*)zr, vw = *(const u32x4*)(zr + 1024); mixc_put(KS, VS, kw, vw, row * 64 + skc, sch, kn_g); }
      int have_hi = 7;
      u32x4 qn[2], kn[2], vn[2];
      int nnew = 0;
#pragma unroll
      for (int s = 0; s < 2; ++s) qn[s] = *(const u32x4*)(zq + (size_t)qr * 64 * 3072 + 32 * s);
      for (int rp = 0; rp < 16; ++rp) {
        const int r0 = 2 * rp;
        if (nnew > 0) mixc_put(KS, VS, kn[0], vn[0], ((have_hi + 1) % 9) * 64 + skc, sch, kn_g);
        if (nnew > 1) mixc_put(KS, VS, kn[1], vn[1], ((have_hi + 2) % 9) * 64 + skc, sch, kn_g);
        have_hi += nnew;
        const int rq = r0 + qr, cq = 16 * n + fr;
        bf16x8 Qf[2];
        { float x[16]; float ss = 0.f;
#pragma unroll
          for (int s = 0; s < 2; ++s) { const u32x4 w = qn[s];
              x[8 * s + 0] = bf_lo(w.x); x[8 * s + 1] = bf_hi(w.x); x[8 * s + 2] = bf_lo(w.y); x[8 * s + 3] = bf_hi(w.y); x[8 * s + 4] = bf_lo(w.z); x[8 * s + 5] = bf_hi(w.z); x[8 * s + 6] = bf_lo(w.w); x[8 * s + 7] = bf_hi(w.w); }
#pragma unroll
          for (int j = 0; j < 16; ++j) ss += x[j] * x[j];
          ss += xshfl<16>(ss); ss = sum32x(ss);
          const float rstd = 0.125f * LOG2E / sqrtf(ss * (1.0f / 64.0f) + RMS_EPS);
#pragma unroll
          for (int s = 0; s < 2; ++s) { const f32x4 g0 = *(const f32x4*)(qn_g + 32 * s + 8 * fq), g1 = *(const f32x4*)(qn_g + 32 * s + 8 * fq + 4);
              u32x4 o; o.x = pk2(x[8 * s + 0] * rstd * g0[0], x[8 * s + 1] * rstd * g0[1]); o.y = pk2(x[8 * s + 2] * rstd * g0[2], x[8 * s + 3] * rstd * g0[3]);
              o.z = pk2(x[8 * s + 4] * rstd * g1[0], x[8 * s + 5] * rstd * g1[1]); o.w = pk2(x[8 * s + 6] * rstd * g1[2], x[8 * s + 7] * rstd * g1[3]);
              Qf[s] = __builtin_bit_cast(bf16x8, o); } }
        __syncthreads();
        if (rp < 15) { const int nh = min(max(r0 + 3 - 4, 0), 24) + 7; nnew = nh - have_hi;
            if (nnew > 0) { const bf16* zr = zk + (size_t)((have_hi + 1) * 64 + skc) * 3072; kn[0] = *(const u32x4*)zr; vn[0] = *(const u32x4*)(zr + 1024); }
            if (nnew > 1) { const bf16* zr = zk + (size_t)((have_hi + 2) * 64 + skc) * 3072; kn[1] = *(const u32x4*)zr; vn[1] = *(const u32x4*)(zr + 1024); }
#pragma unroll
            for (int s = 0; s < 2; ++s) qn[s] = *(const u32x4*)(zq + (size_t)(r0 + 2 + qr) * 64 * 3072 + 32 * s); }
        else nnew = 0;
        const int rsq = min(max(rq - 4, 0), 24);
        const int kb = min(max(16 * n - 8, 0), 32);
        const int cs = min(max(cq - 8, 0), 48);
        const int co0 = kb + 4 * fq - cq + 15;
        const int thr = cs - kb;
        bool sel0[4]; int boff[4];
#pragma unroll
        for (int i = 0; i < 4; ++i) { sel0[i] = (4 * fq + i) >= thr; boff[i] = co0 + i + (sel0[i] ? 0 : 16); }
        f32x4 sc[8]; float mx = -1e30f;
#pragma unroll
        for (int a8 = 0; a8 < 8; ++a8) { const int key = ((rsq + a8) % 9) * 64 + kb + fr;
            f32x4 acc0 = {0.f, 0.f, 0.f, 0.f}, acc1 = {0.f, 0.f, 0.f, 0.f};
#pragma unroll
            for (int s = 0; s < 2; ++s) { const bf16x8 kf0 = *(const LAS bf16x8*)(KS + key * 64 + (((4 * s + fq) ^ (key & 7)) * 8)), kf1 = *(const LAS bf16x8*)(KS + (key + 16) * 64 + (((4 * s + fq) ^ ((key + 16) & 7)) * 8));
                acc0 = __builtin_amdgcn_mfma_f32_16x16x32_bf16(kf0, Qf[s], acc0, 0, 0, 0); acc1 = __builtin_amdgcn_mfma_f32_16x16x32_bf16(kf1, Qf[s], acc1, 0, 0, 0); }
            const LAS float* bt = BT + (rsq + a8 - rq + 7) * 32;
            float bv0 = bt[boff[0]], bv1 = bt[boff[1]], bv2 = bt[boff[2]], bv3 = bt[boff[3]];
            asm volatile("" : "+v"(bv0), "+v"(bv1), "+v"(bv2), "+v"(bv3));
            const float bvv[4] = {bv0, bv1, bv2, bv3};
            f32x4 sv;
#pragma unroll
            for (int i = 0; i < 4; ++i) { sv[i] = (sel0[i] ? acc0[i] : acc1[i]) + bvv[i]; mx = fmaxf(mx, sv[i]); }
            sc[a8] = sv; }
        mx = fmaxf(mx, xshfl<16>(mx)); mx = max32x(mx);
        float ls = 0.f;
#pragma unroll
        for (int a8 = 0; a8 < 8; ++a8)
#pragma unroll
            for (int i = 0; i < 4; ++i) { const float pv = fexp2(sc[a8][i] - mx); sc[a8][i] = pv; ls += pv; }
        ls += xshfl<16>(ls); ls = sum32x(ls);
        const float inv = 1.0f / ls;
        f32x4 O[4];
#pragma unroll
        for (int dt = 0; dt < 4; ++dt) O[dt] = (f32x4){0.f, 0.f, 0.f, 0.f};
        const unsigned pm01 = (sel0[0] ? 0xffffu : 0u) | (sel0[1] ? 0xffff0000u : 0u), pm23 = (sel0[2] ? 0xffffu : 0u) | (sel0[3] ? 0xffff0000u : 0u);
#pragma unroll
        for (int ks = 0; ks < 8; ++ks) {
            const unsigned pa = pk2(sc[ks][0], sc[ks][1]), pb_ = pk2(sc[ks][2], sc[ks][3]);
            u32x4 o; o.x = pa & pm01; o.y = pb_ & pm23; o.z = pa & ~pm01; o.w = pb_ & ~pm23;
            const bf16x8 pf = __builtin_bit_cast(bf16x8, o);
            const int k0 = ((rsq + ks) % 9) * 64 + kb + 4 * fq + (fr >> 2), k1 = k0 + 16;
            const int sw0 = ((k0 >> 1) & 3) << 1, sw1 = ((k1 >> 1) & 3) << 1;
#pragma unroll
            for (int dt = 0; dt < 4; ++dt) { const int c16 = 2 * dt + ((fr & 3) >> 1), h8 = 4 * (fr & 1);
                const s16x4 lo = __builtin_amdgcn_ds_read_tr16_b64_v4i16((LAS s16x4*)(VS + k0 * 64 + ((c16 ^ sw0) * 8) + h8));
                const s16x4 hi = __builtin_amdgcn_ds_read_tr16_b64_v4i16((LAS s16x4*)(VS + k1 * 64 + ((c16 ^ sw1) * 8) + h8));
                const bf16x8 vf = __builtin_shufflevector(lo, hi, 0, 1, 2, 3, 4, 5, 6, 7);
                O[dt] = __builtin_amdgcn_mfma_f32_16x16x32_bf16(vf, pf, O[dt], 0, 0, 0); } }
        bf16* orow = mix + (tokb + (size_t)rq * 64 + cq) * D + head * 64;
#pragma unroll
        for (int dt = 0; dt < 4; ++dt) { u32x2 w; w.x = pk2(O[dt][0] * inv, O[dt][1] * inv); w.y = pk2(O[dt][2] * inv, O[dt][3] * inv); *(u32x2*)(orow + 16 * dt + 4 * fq) = w; }
        __syncthreads();
      }
    }
}

constexpr int NPH = 9, N_PHASES = 1 + DEPTH * NPH;
__global__ void __launch_bounds__(NTHREADS, 2) fwd(Args args) {
    extern __shared__ __attribute__((aligned(16))) unsigned char lds_raw[];
    Frame F;
    F.lds = (LAS unsigned char*)lds_raw;
    F.tid = threadIdx.x; F.lane = F.tid & 63; F.wave = __builtin_amdgcn_readfirstlane(F.tid >> 6);
    F.G = gridDim.x; { const int bx = blockIdx.x; F.vcu = (F.G % 8 == 0) ? (bx % 8) * (F.G / 8) + bx / 8 : bx; }
    F.in = (kin_t)__builtin_amdgcn_kernarg_segment_ptr(); F.out = args.out; F.ws = args.ws;
    volatile LAS unsigned* MISC = (volatile LAS unsigned*)(F.lds + MISC_OFF);
    if (F.tid < 64) MISC[F.tid] = 0u;
    __syncthreads();
    const int lo = args.ph_lo, hi = args.ph_hi;
    const bool multi = (hi - lo) > 1;
    unsigned* barw = (unsigned*)(F.ws + WS_CTL) + CW_BAR;
    XcdBarrier bar; bar.bar = barw; bar.x = 0; bar.st = nullptr;
    if (multi) bar = xcd_barrier_post(barw, MISC + 8);
#ifndef PHMASK
#define PHMASK 0xFFFFu
#endif
#define IN(k) (lo <= (k) && (k) < hi)
#define ON(k) ((PHMASK >> (k)) & 1u)
#ifndef PROBE_REPEAT
#define PROBE_REPEAT 0u
#endif
#define REP(k) ((PROBE_REPEAT >> (k)) & 1u)
#define SEAM(k) do { if (IN((k) + 1)) xcd_barrier(bar, F.wave); } while (0)

    if (ON(0) && IN(0)) { p_convert(F); if (REP(0)) p_convert(F); SEAM(0); }

#define PH_BEGIN unsigned char* ws = opaque_p(F.ws); kin_t inp = opaque_k(F.in); float* outp = opaque_p(F.out); (void)ws; (void)inp; (void)outp; \
        unsigned char* wl = ws + WS_W + (size_t)L * WL_STRIDE; (void)wl; \
        bf16* Hc = (L & 1) ? (bf16*)(ws + WS_XN) : (bf16*)outp; bf16* Hn = (L & 1) ? (bf16*)outp : (bf16*)(ws + WS_XN); (void)Hc; (void)Hn
#define P_R1 ((bf16*)(ws + WS_R1))
#define P_R2 ((bf16*)(ws + WS_R2))
#define P_HN8 ((unsigned char*)(ws + WS_R2 + 128 * MiB))
#define P_PROJ ((bf16*)(ws + WS_R1 + 128 * MiB))
#define P_HB8 ((unsigned char*)(ws + WS_R1 + 256 * MiB))
#define P_AFF ((float*)(ws + WS_AFF))
#define P_IDX ((int*)(ws + WS_IDX))
#define P_GATEV ((float*)(ws + WS_GATEV))
#define P_RSTD1 ((float*)(ws + WS_RSTD1))
#define P_RSTD ((float*)(ws + WS_RSTD))
#define P_RSTD3 ((float*)(ws + WS_RSTD3))
#define P_RSEL ((float*)(ws + WS_RSEL))
#define P_SLOT ((int*)(ws + WS_SLOT))
#ifndef MIXMASK
#define MIXMASK 7
#endif
    for (int L = 0; L < DEPTH; ++L) {
        const int pb = 1 + L * NPH, kind = L % 3, j = L / 3;
        if (ON(1) && IN(pb + 0)) { PH_BEGIN;
            const int nin = kind == 0 ? 2048 : (kind == 1 ? 1536 : 3072);
            for (int rep = 0; rep < (REP(1) ? 2 : 1); ++rep) {
            if ((FP8_IN_MASK >> L) & 1) {
                pg8::StaticOrder S; S.init(P_HN8, wl + WL_IN, T, nin, D / 2, F.G, (int)blockIdx.x);
                pg8::EpiIn<0> E{P_R1, nin, P_RSTD1, nullptr}; pg8::gemm_phase<pg8::EpiIn<0>, pg8::StaticOrder, false, true>(F.lds, F.wave, D / 2, S, E);
            } else {
            pg8::StaticOrder S; S.init(Hc, wl + WL_IN, T, nin, D, F.G, (int)blockIdx.x);
            if (kind == 0) { pg8::EpiIn<1> E{P_R1, nin, P_RSTD1, (float*)(ws + WS_VST)}; pg8::gemm_phase<pg8::EpiIn<1>, pg8::StaticOrder>(F.lds, F.wave, D, S, E); }
            else { pg8::EpiIn<0> E{P_R1, nin, P_RSTD1, nullptr}; pg8::gemm_phase<pg8::EpiIn<0>, pg8::StaticOrder>(F.lds, F.wave, D, S, E); }
            }
            }
            SEAM(pb + 0);
        }
        if (ON(2) && IN(pb + 1)) { PH_BEGIN;
#ifndef PROBE_MIXKIND
#define PROBE_MIXKIND -1
#endif
#ifndef PROBE_MIXREPN
#define PROBE_MIXREPN 2
#endif
            for (int rep = 0; rep < ((REP(2) && (PROBE_MIXKIND < 0 || PROBE_MIXKIND == kind)) ? PROBE_MIXREPN : 1); ++rep) {
            if ((MIXMASK & 1) && kind == 0) p_mix_a(F, P_R1, GIN(inp, IN_AVN) + (size_t)j * 1024, (const bf16*)(ws + WS_WSA) + (size_t)j * 8 * 128 * 128, GIN(inp, IN_ABS) + (size_t)j * 8 * 128, P_R2, (const float*)(ws + WS_VST));
            else if ((MIXMASK & 2) && kind == 1) p_mix_b(F, P_R1, GIN(inp, IN_BQN), GIN(inp, IN_BKN), GIN(inp, IN_BSINK), P_R2);
            else if ((MIXMASK & 4) && kind == 2) p_mix_c(F, P_R1, GIN(inp, IN_CQN), GIN(inp, IN_CKN), GIN(inp, IN_CRPB), P_R2);
            }
            SEAM(pb + 1);
        }
        if (ON(3) && IN(pb + 2)) { PH_BEGIN;
            if (REP(3)) { pg8::StaticOrder S; S.init(P_R2, wl + WL_OUT, T, D, D, F.G, (int)blockIdx.x);
                pg8::EpiRes E{Hc, Hn}; pg8::gemm_phase<pg8::EpiRes, pg8::StaticOrder>(F.lds, F.wave, D, S, E); }
            pg8::StaticOrder S; S.init(P_R2, wl + WL_OUT, T, D, D, F.G, (int)blockIdx.x);
            pg8::EpiRes E{Hc, Hc}; pg8::gemm_phase<pg8::EpiRes, pg8::StaticOrder>(F.lds, F.wave, D, S, E);
            SEAM(pb + 2);
        }
        if (ON(4) && IN(pb + 3)) { PH_BEGIN;
            for (int rep = 0; rep < (REP(4) ? 2 : 1); ++rep) p_router(F, Hc, GIN(inp, IN_NFFN) + (size_t)L * D, GIN(inp, IN_ROUTER) + (size_t)L * D * NE, P_RSTD, P_AFF, P_HB8);
            SEAM(pb + 3); }
        if (ON(5) && IN(pb + 4)) { PH_BEGIN;
            for (int rep = 0; rep < (REP(5) ? 2 : 1); ++rep) p_topk(F, P_AFF, P_RSTD, P_IDX, P_GATEV, P_RSEL, P_SLOT);
            SEAM(pb + 4); }
        if (ON(6) && IN(pb + 5)) { PH_BEGIN;
            for (int rep = 0; rep < (REP(6) ? 2 : 1); ++rep) {
            pg8::GroupedOrder S; S.init(P_HB8, wl + WL_GU, D / 2, 8, (size_t)2 * FF * D, F.G, (int)blockIdx.x, (size_t)SEQ * D);
            LAS unsigned short* gtab = (LAS unsigned short*)(F.lds + LDS_SPARE);
            LAS float* rtab = (LAS float*)(F.lds + LDS_SPARE + 8192);
            { const int* idx = P_IDX; const float* rsel = P_RSEL; const int tid = F.wave * 64 + lane_id();
              for (int i = 0; i < 16; ++i) { pg8::Unit u; if (!S.next(i, u)) break;
                  if (tid < 256) gtab[i * 256 + tid] = (unsigned short)idx[u.pm * CAP + tid]; else rtab[i * 256 + tid - 256] = rsel[u.pm * CAP + tid - 256]; }
              __syncthreads(); }
#ifndef PROBE_GU_FIXED
#define PROBE_GU_FIXED 0
#endif
            if (PROBE_GU_FIXED) { pg8::FixedTileOrder Sf; Sf.init(P_HB8, wl + WL_GU, D / 2, 8, (size_t)2 * FF * D, F.G, (int)blockIdx.x, (size_t)SEQ * D);
                pg8::EpiGU Ef{(unsigned char*)P_R2, rtab}; if (PROBE_GU_FIXED == 1) pg8::gemm_phase<pg8::EpiGU, pg8::FixedTileOrder, false, true>(F.lds, F.wave, D / 2, Sf, Ef);
                else pg8::gemm_phase<pg8::EpiGU, pg8::GroupedOrder, true, true>(F.lds, F.wave, D / 2, S, Ef, gtab); }
            pg8::EpiGU E{(unsigned char*)P_R2, rtab}; pg8::gemm_phase<pg8::EpiGU, pg8::GroupedOrder, true, true>(F.lds, F.wave, D / 2, S, E, gtab);
            }
            SEAM(pb + 5);
        }
        if (ON(7) && IN(pb + 6)) { PH_BEGIN;
            for (int rep = 0; rep < (REP(7) ? 2 : 1); ++rep) {
            pg8::GroupedOrder S; S.init(P_R2, wl + WL_DN, FF / 2, 4, (size_t)D * FF, F.G, (int)blockIdx.x);
            pg8::EpiDown E{(unsigned char*)P_R1, P_GATEV}; pg8::gemm_phase<pg8::EpiDown, pg8::GroupedOrder, false, true>(F.lds, F.wave, FF / 2, S, E);
            }
            SEAM(pb + 6);
        }
        if (ON(8) && IN(pb + 7)) { PH_BEGIN;
            if (REP(8)) p_combine(F, Hc, Hn, (const unsigned char*)P_R1, P_SLOT, P_RSTD3, GIN(inp, IN_P) + (size_t)L * T * PLE, P_R2, P_HB8);
            p_combine(F, Hc, Hc, (const unsigned char*)P_R1, P_SLOT, P_RSTD3, GIN(inp, IN_P) + (size_t)L * T * PLE, P_R2, P_HB8);
            VM_WAIT(); __syncthreads(); __builtin_amdgcn_fence(__ATOMIC_ACQUIRE, "agent"); VM_WAIT(); __syncthreads(); }
        if (ON(9) && IN(pb + 8)) {
#ifndef PROBE_PLEPART
#define PROBE_PLEPART 3
#endif
            for (int rep = 0; rep < (REP(9) ? 2 : 1); ++rep) {
            if (rep == 0 || (PROBE_PLEPART & 1))
            { PH_BEGIN; pg8::PanelOrder S; S.init(P_R2, wl + WL_PP, PLE, T / 256, D / 256, F.G, (int)blockIdx.x);
              pg8::EpiProj E{P_PROJ}; pg8::gemm_phase<pg8::EpiProj, pg8::PanelOrder>(F.lds, F.wave, PLE, S, E); }
            if (rep == 0 || (PROBE_PLEPART & 2)) {
            __builtin_amdgcn_fence(__ATOMIC_ACQUIRE, "agent");
            { PH_BEGIN; pg8::PanelOrder S; S.init(P_HB8, wl + WL_PG, D / 2, T / 256, D / 256, F.G, (int)blockIdx.x);
              LAS float* part = (LAS float*)(F.lds + LDS_SPARE);
              pg8::EpiPle E{Hc, P_PROJ, Hn, outp, P_RSTD3, part, L == DEPTH - 1 ? 1 : 0, (L + 1 < DEPTH && ((FP8_IN_MASK >> (L + 1)) & 1)) ? P_HN8 : (unsigned char*)nullptr}; pg8::gemm_phase<pg8::EpiPle, pg8::PanelOrder, false, true>(F.lds, F.wave, D / 2, S, E);
              if (L != DEPTH - 1) {
                  __syncthreads();
                  const int tid = F.wave * 64 + lane_id();
                  if (tid < 256) { const LAS f32x4* pr = (const LAS f32x4*)(part + tid * 16); const f32x4 a = pr[0], b = pr[1], c = pr[2], d = pr[3];
                      const float ss = ((a[0] + a[1]) + (a[2] + a[3])) + ((b[0] + b[1]) + (b[2] + b[3])) + ((c[0] + c[1]) + (c[2] + c[3])) + ((d[0] + d[1]) + (d[2] + d[3]));
                      P_RSTD1[(size_t)blockIdx.x * 256 + tid] = 1.0f / sqrtf(ss * (1.0f / D) + RMS_EPS); }
                  __syncthreads(); } }
            }
            }
            SEAM(pb + 8);
        }
    }
#undef IN
#undef SEAM
}

extern "C" void kernel_launch(void* const* d_in, const int* in_sizes, int n_in, void* d_out, int out_size, void* d_ws, size_t ws_size, hipStream_t stream) {
    static int grid = 0;
    if (grid == 0) {
        if (n_in != 24 || out_size != T * D || ws_size < WS_END) { fprintf(stderr, "kernel_launch: unexpected shapes: n_in %d out %d ws %zu (need %zu)\n", n_in, out_size, ws_size, (size_t)WS_END); grid = -1; return; }
        int dev = 0, cus = 0, per_cu = 0;
        if (hipGetDevice(&dev) != hipSuccess || hipDeviceGetAttribute(&cus, hipDeviceAttributeMultiprocessorCount, dev) != hipSuccess) { grid = -1; return; }
        if (hipFuncSetAttribute((const void*)fwd, hipFuncAttributeMaxDynamicSharedMemorySize, LDS_BYTES) != hipSuccess) { fprintf(stderr, "kernel_launch: hipFuncSetAttribute failed\n"); grid = -1; return; }
        if (hipOccupancyMaxActiveBlocksPerMultiprocessor(&per_cu, (const void*)fwd, NTHREADS, LDS_BYTES) != hipSuccess || per_cu < 1) fprintf(stderr, "kernel_launch: occupancy query reports %d\n", per_cu);
        (void)hipGetLastError();
        grid = cus;
        if (grid != 256) fprintf(stderr, "kernel_launch: built for a 256-CU device (one workgroup per 256-row panel); got %d CUs\n", cus);
    }
    if (grid < 0) return;
    (void)hipMemsetAsync((char*)d_ws + WS_CTL, 0, CTL_ZERO_BYTES, stream);
    Args a{};
    for (int i = 0; i < 24; ++i) a.in[i] = (const float*)d_in[i];
    a.out = (float*)d_out; a.ws = (unsigned char*)d_ws;
#if MK_ONE_LAUNCH
    a.ph_lo = 0; a.ph_hi = N_PHASES;
    hipLaunchKernelGGL(fwd, dim3(grid), dim3(NTHREADS), LDS_BYTES, stream, a);
#else
    for (int k = 0; k < N_PHASES; ++k) { a.ph_lo = k; a.ph_hi = k + 1; hipLaunchKernelGGL(fwd, dim3(grid), dim3(NTHREADS), LDS_BYTES, stream, a); }
#endif
}
```

```cpp
#include <hip/hip_runtime.h>
#include <cstdio>
#include <cstdint>

#ifndef MK_ONE_LAUNCH
#define MK_ONE_LAUNCH 1
#endif

#ifndef FP8_IN_MASK
#define FP8_IN_MASK 0x6
#endif
#define GAS __attribute__((address_space(1)))
#define LAS __attribute__((address_space(3)))
typedef unsigned short bf16;
typedef short bf16x8 __attribute__((ext_vector_type(8)));
typedef short s16x4 __attribute__((ext_vector_type(4)));
typedef float f32x4 __attribute__((ext_vector_type(4)));
typedef float f32x2 __attribute__((ext_vector_type(2)));
typedef float f32x16 __attribute__((ext_vector_type(16)));
typedef unsigned u32x4 __attribute__((ext_vector_type(4)));
typedef unsigned u32x2 __attribute__((ext_vector_type(2)));
typedef __bf16 bf16x2_t __attribute__((ext_vector_type(2)));

constexpr int D = 1024, NBATCH = 32, SEQ = 2048, T = NBATCH * SEQ, DEPTH = 4, PLE = 256, NE = 16, FF = 1024, CAP = 256;
constexpr int M2 = NBATCH * NE * CAP;
constexpr int NWAVES = 8, NTHREADS = 512;
constexpr float RMS_EPS = 1e-6f, LN_EPS = 1e-5f, LOG2E = 1.4426950408889634f;

constexpr size_t MiB = 1u << 20;
constexpr size_t WS_CTL = 0, CTL_ZERO_BYTES = 32 * 1024;
constexpr size_t WS_AFF = 1 * MiB;
constexpr size_t WS_IDX = 5 * MiB;
constexpr size_t WS_GATEV = 5 * MiB + 512 * 1024;
constexpr size_t WS_SLOT = 6 * MiB;
constexpr size_t WS_WSA = 10 * MiB;
constexpr size_t WS_RSTD1 = 10 * MiB + 512 * 1024;
constexpr size_t WS_RSTD3 = 10 * MiB + 768 * 1024;
constexpr size_t WS_RSTD = 11 * MiB;
constexpr size_t WS_RSEL = 11 * MiB + 512 * 1024;
constexpr size_t WS_W = 12 * MiB, WL_STRIDE = 107 * MiB;
constexpr size_t WL_IN = 0, WL_OUT = 6 * MiB, WL_GU = 8 * MiB, WL_DN = 72 * MiB, WL_PG = 104 * MiB, WL_PP = 106 * MiB;
constexpr size_t WS_VST = WS_W + 1 * WL_STRIDE + WL_GU + 32 * MiB;
constexpr size_t WS_XN = WS_W + 4 * WL_STRIDE;
constexpr size_t WS_R1 = WS_XN + 128 * MiB;
constexpr size_t WS_R2 = WS_R1 + 384 * MiB;
constexpr size_t WS_END = WS_R2 + 256 * MiB;
constexpr int CW_BAR = 4096;

constexpr int LDS_BYTES = 160 * 1024;
constexpr int MISC_OFF = LDS_BYTES - 256;
constexpr int LDS_SPARE = 131072;

#define LDS_WAIT() asm volatile("s_waitcnt lgkmcnt(0)" ::: "memory")
#define VM_WAIT() asm volatile("s_waitcnt vmcnt(0)" ::: "memory")
__device__ __forceinline__ unsigned pk2(float lo, float hi) { f32x2 v = {lo, hi}; bf16x2_t b = __builtin_convertvector(v, bf16x2_t); return __builtin_bit_cast(unsigned, b); }
__device__ __forceinline__ float bf_lo(unsigned w) { return __uint_as_float(w << 16); }
__device__ __forceinline__ float bf_hi(unsigned w) { return __uint_as_float(w & 0xffff0000u); }
__device__ __forceinline__ float bf1(bf16 b) { return __uint_as_float(((unsigned)b) << 16); }
__device__ __forceinline__ bf16 f2bf(float f) { return (bf16)(pk2(f, 0.f) & 0xffffu); }
template <int M> __device__ __forceinline__ float xshfl(float v) { return __int_as_float(__builtin_amdgcn_ds_swizzle(__float_as_int(v), (M << 10) | 0x1f)); }
__device__ __forceinline__ float sum32x(float v) { auto r = __builtin_amdgcn_permlane32_swap(__float_as_uint(v), __float_as_uint(v), false, false); return __uint_as_float(r[0]) + __uint_as_float(r[1]); }
__device__ __forceinline__ float max32x(float v) { auto r = __builtin_amdgcn_permlane32_swap(__float_as_uint(v), __float_as_uint(v), false, false); return fmaxf(__uint_as_float(r[0]), __uint_as_float(r[1])); }
__device__ __forceinline__ u32x4 widen16(const u32x2 a, const u32x2 b) { auto rx = __builtin_amdgcn_permlane16_swap(a.x, b.x, false, false); auto ry = __builtin_amdgcn_permlane16_swap(a.y, b.y, false, false);
    u32x4 o; o.x = rx[0]; o.y = ry[0]; o.z = rx[1]; o.w = ry[1]; return o; }
__device__ __forceinline__ float wave_sum(float v) { v += xshfl<1>(v); v += xshfl<2>(v); v += xshfl<4>(v); v += xshfl<8>(v); v += xshfl<16>(v); return sum32x(v); }
__device__ __forceinline__ float wave_max(float v) { v = fmaxf(v, xshfl<1>(v)); v = fmaxf(v, xshfl<2>(v)); v = fmaxf(v, xshfl<4>(v)); v = fmaxf(v, xshfl<8>(v)); v = fmaxf(v, xshfl<16>(v)); return max32x(v); }
__device__ __forceinline__ unsigned opaque(unsigned x) { asm volatile("" : "+v"(x)); return x; }
typedef const float* cfp0_t;
typedef const __attribute__((address_space(4))) cfp0_t* kin0_t;
__device__ __forceinline__ kin0_t opaque_k(kin0_t p) { unsigned long long v = (unsigned long long)p; unsigned lo = (unsigned)v, hi = (unsigned)(v >> 32); asm volatile("" : "+v"(lo), "+v"(hi));
    lo = __builtin_amdgcn_readfirstlane(lo); hi = __builtin_amdgcn_readfirstlane(hi); return (kin0_t)(((unsigned long long)hi << 32) | lo); }
template <class P> __device__ __forceinline__ P* opaque_p(P* p) { unsigned long long v = (unsigned long long)p; unsigned lo = (unsigned)v, hi = (unsigned)(v >> 32); asm volatile("" : "+v"(lo), "+v"(hi));
    lo = __builtin_amdgcn_readfirstlane(lo); hi = __builtin_amdgcn_readfirstlane(hi); return (P*)(GAS P*)(((unsigned long long)hi << 32) | lo); }
__device__ __forceinline__ int lane_id() { int l; asm volatile("v_mbcnt_lo_u32_b32 %0, -1, 0\n\tv_mbcnt_hi_u32_b32 %0, -1, %0" : "=v"(l)); return l; }
__device__ __forceinline__ int opaque_i(int x) { asm volatile("" : "+v"(x)); return x; }
__device__ __forceinline__ u32x2 pack8_fp8(const float (&x)[8]) {
    unsigned a = 0u, b = 0u;
    a = (unsigned)__builtin_amdgcn_cvt_pk_fp8_f32(x[0], x[1], (int)a, false); a = (unsigned)__builtin_amdgcn_cvt_pk_fp8_f32(x[2], x[3], (int)a, true);
    b = (unsigned)__builtin_amdgcn_cvt_pk_fp8_f32(x[4], x[5], (int)b, false); b = (unsigned)__builtin_amdgcn_cvt_pk_fp8_f32(x[6], x[7], (int)b, true);
    u32x2 r; r.x = a; r.y = b; return r;
}
__device__ __forceinline__ void unpack8_fp8(const u32x2 w, float (&x)[8]) {
    const f32x2 a = __builtin_amdgcn_cvt_pk_f32_fp8((int)w.x, false), b = __builtin_amdgcn_cvt_pk_f32_fp8((int)w.x, true), c = __builtin_amdgcn_cvt_pk_f32_fp8((int)w.y, false), d = __builtin_amdgcn_cvt_pk_f32_fp8((int)w.y, true);
    x[0] = a[0]; x[1] = a[1]; x[2] = b[0]; x[3] = b[1]; x[4] = c[0]; x[5] = c[1]; x[6] = d[0]; x[7] = d[1];
}
__device__ __forceinline__ float fexp2(float x) { return __builtin_amdgcn_exp2f(x); }
__device__ __forceinline__ float frcp(float x) { return __builtin_amdgcn_rcpf(x); }

namespace pg8 {
constexpr int BM = 256, BK = 64, HALF = 128, HTB = HALF * BK * 2, STAGE_BYTES = 8 * HTB, NXCD = 8, WGM = 8;
__host__ __device__ __forceinline__ int lds_byte(int r, int c) { const int st = (r >> 4) * 2 + (c >> 5), rr = r & 15, cc = c & 31, ob = rr * 64 + cc * 2; return st * 1024 + (ob ^ (((ob >> 9) & 1) << 5)); }
__host__ __device__ __forceinline__ void stage_rc(int b, int& R, int& C) { const int st = b / 1024, sb = b % 1024, swz = sb ^ (((sb >> 9) & 1) << 5); R = (st >> 1) * 16 + swz / 64; C = (st & 1) * 32 + (swz % 64) / 2; }
__host__ __device__ __forceinline__ int perm32(int rho) { const int n = rho >> 4, i = rho & 15; return 8 * (i >> 2) + 4 * n + (i & 3); }

__device__ __forceinline__ void glds16(const char* sbase, unsigned voff, unsigned lds_dst) {
    unsigned keep;
    asm volatile("s_mov_b32 %0, m0\n\ts_mov_b32 m0, %3\n\ts_nop 0\n\tglobal_load_lds_dwordx4 %1, %2\n\ts_mov_b32 m0, %0" : "=&s"(keep) : "v"(voff), "s"(sbase), "s"(lds_dst) : "memory");
}
struct Unit { int pm, pn; };

struct StaticOrder {
    const char* A; const char* Bt; size_t tstep;
    int nM, nN, nwg, G, c;
    __device__ void init(const void* A_, const void* Bt_, int M, int N, int K, int G_, int c_) { A = (const char*)A_; Bt = (const char*)Bt_; tstep = (size_t)BM * K * 2; nM = M / BM; nN = N / BM; nwg = nM * nN; G = G_; c = c_; }
    __device__ __forceinline__ bool next(int i, Unit& u) const {
        const long L = (long)i * G + c; if (L >= nwg) return false;
        int wgid = (int)L; { const int q = nwg / NXCD, r = nwg % NXCD, xcd = wgid % NXCD, off = wgid / NXCD; wgid = (xcd < r ? xcd * (q + 1) : r * (q + 1) + (xcd - r) * q) + off; }
        const int nig = WGM * nN, gid = wgid / nig, fm = gid * WGM, gsz = (nM - fm) < WGM ? (nM - fm) : WGM;
        u.pm = fm + ((wgid % nig) % gsz); u.pn = (wgid % nig) / gsz; return true;
    }
    __device__ __forceinline__ const char* a_ptr(const Unit& u) const { return A + (size_t)u.pm * tstep; }
    __device__ __forceinline__ const char* b_ptr(const Unit& u) const { return Bt + (size_t)u.pn * tstep; }
};
struct GroupedOrder {
    const char* A; const char* Bt; size_t tstep, estride;
    int NT, nunits, G, c; size_t bstride;
    __device__ void init(const void* A_, const void* Bt_, int K, int NT_, size_t estride_bytes, int G_, int c_, size_t bstride_ = 0) { A = (const char*)A_; Bt = (const char*)Bt_; tstep = (size_t)BM * K * 2; estride = estride_bytes; NT = NT_; nunits = NBATCH * NE * NT_; G = G_; c = c_; bstride = bstride_; }
    __device__ __forceinline__ bool next(int i, Unit& u) const {
        const long L = (long)i * G + c; if (L >= nunits) return false;
        const int x = (int)L & 7, q = (int)L >> 3, s = q & 31, ii = q >> 5;
        const int e = 2 * x + ii / NT, j = ii % NT, pn = s % NT, b = (32 / NT) * j + s / NT;
        u.pm = b * NE + e; u.pn = pn; return true;
    }
    __device__ __forceinline__ const char* a_ptr(const Unit& u) const { return bstride ? A + (size_t)(u.pm >> 4) * bstride : A + (size_t)u.pm * tstep; }
    __device__ __forceinline__ const char* b_ptr(const Unit& u) const { return Bt + (size_t)(u.pm & (NE - 1)) * estride + (size_t)u.pn * tstep; }
};

struct PanelOrder {
    const char* A; const char* Bt; size_t tstep; int nN, nP, G, c;
    __device__ void init(const void* A_, const void* Bt_, int K, int nP_, int nN_, int G_, int c_) { A = (const char*)A_; Bt = (const char*)Bt_; tstep = (size_t)BM * K * 2; nN = nN_; nP = nP_; G = G_; c = c_; }
    __device__ __forceinline__ bool next(int i, Unit& u) const { const int pm = c + (i / nN) * G; if (pm >= nP) return false; u.pm = pm; u.pn = i % nN; return true; }
    __device__ __forceinline__ const char* a_ptr(const Unit& u) const { return A + (size_t)u.pm * tstep; }
    __device__ __forceinline__ const char* b_ptr(const Unit& u) const { return Bt + (size_t)u.pn * tstep; }
};
struct FixedTileOrder : GroupedOrder {
    __device__ __forceinline__ const char* a_ptr(const Unit&) const { return Bt; }
    __device__ __forceinline__ const char* b_ptr(const Unit&) const { return Bt; }
};
typedef f32x4 Acc[2][2][4][2];

constexpr int FP8_WEXP = 6;
#ifndef PG8_ALIGN_DEF
#define PG8_ALIGN_DEF true
#endif
#ifndef PG8_SP2_DEF
#define PG8_SP2_DEF true
#endif
template <class Epi, class Sched, bool GATHER = false, bool FP8 = false, bool ALIGN_EPI = PG8_ALIGN_DEF, bool SP2 = PG8_SP2_DEF>
__device__ __forceinline__ void gemm_phase(LAS unsigned char* lds, const int wave_id, const int K, const Sched& S, const Epi& E, const LAS unsigned short* gtab = nullptr) {
    const int lane = opaque_i(lane_id()), wid = __builtin_amdgcn_readfirstlane(opaque_i(wave_id)), tid = wid * 64 + lane, wr = wid >> 2, wc = wid & 3, fr = lane & 15, fq = lane >> 4;
    const int nt = K / BK;
    unsigned voffA[2], voffB[2]; int gR[2];
#pragma unroll
    for (int i = 0; i < 2; ++i) { int R, C; stage_rc(tid * 16 + i * 8192, R, C); const int Rb = Epi::PERM ? ((R & ~31) + perm32(R & 31)) : R;
        voffA[i] = GATHER ? (unsigned)C * 2u : (unsigned)(R * K + C) * 2u; voffB[i] = (unsigned)(Rb * K + C) * 2u; gR[i] = R; }
    unsigned vC[2][2];
    const size_t kstep = (size_t)(BK * 2);
    const size_t hstep = (size_t)HALF * K * 2;
    const unsigned ldsw = (unsigned)wid * 1024u, ldsb = (unsigned)(size_t)lds;
    const int aoff = lds_byte(wr * 64 + fr, fq * 8), boff = lds_byte(wc * 32 + fr, fq * 8);
#define PG8_SA(b, h) (((b) * 2 + (h)) * HTB)
#define PG8_SB(b, h) ((4 + (b) * 2 + (h)) * HTB)
#define PG8_STAGE(bufoff, gbase, voff) do { _Pragma("unroll") for (int _i = 0; _i < 2; ++_i) glds16((const char*)(gbase), (voff)[_i], ldsb + (unsigned)(bufoff) + ldsw + (unsigned)(_i * 8192)); } while (0)
#define PG8_STAGE_A(bufoff, gbase, h, nx) do { _Pragma("unroll") for (int _i = 0; _i < 2; ++_i) { \
        if constexpr (GATHER) glds16((const char*)(gbase), vC[h][_i], ldsb + (unsigned)(bufoff) + ldsw + (unsigned)(_i * 8192)); \
        else glds16((const char*)(gbase) + (size_t)(h) * hstep, voffA[_i], ldsb + (unsigned)(bufoff) + ldsw + (unsigned)(_i * 8192)); } } while (0)
#define PG8_GLOAD(dst, ui_) do { _Pragma("unroll") for (int h_ = 0; h_ < 2; ++h_) _Pragma("unroll") for (int i_ = 0; i_ < 2; ++i_) dst[h_][i_] = ((unsigned)gtab[(ui_) * 256 + h_ * HALF + gR[i_]] << 10) + voffA[i_]; } while (0)
#define PG8_LDA(dst, b, h) do { if constexpr (FP8) { _Pragma("unroll") for (int m = 0; m < 4; ++m) { const v4i_ p0_ = *(const LAS v4i_*)(lds + PG8_SA(b, h) + aoff + m * 2048), p1_ = *(const LAS v4i_*)(lds + PG8_SA(b, h) + aoff + m * 2048 + 1024); \
            dst##8[m] = __builtin_shufflevector(p0_, p1_, 0, 1, 2, 3, 4, 5, 6, 7); } } \
        else { _Pragma("unroll") for (int m = 0; m < 4; ++m) _Pragma("unroll") for (int k = 0; k < 2; ++k) dst[m][k] = *(const LAS bf16x8*)(lds + PG8_SA(b, h) + aoff + m * 2048 + k * 1024); } } while (0)
#define PG8_LDB(dst, b, h) do { if constexpr (FP8) { _Pragma("unroll") for (int n = 0; n < 2; ++n) { const v4i_ p0_ = *(const LAS v4i_*)(lds + PG8_SB(b, h) + boff + n * 2048), p1_ = *(const LAS v4i_*)(lds + PG8_SB(b, h) + boff + n * 2048 + 1024); \
            dst##8[n] = __builtin_shufflevector(p0_, p1_, 0, 1, 2, 3, 4, 5, 6, 7); } } \
        else { _Pragma("unroll") for (int n = 0; n < 2; ++n) _Pragma("unroll") for (int k = 0; k < 2; ++k) dst[n][k] = *(const LAS bf16x8*)(lds + PG8_SB(b, h) + boff + n * 2048 + k * 1024); } } while (0)
#define PG8_MMA(ai, bj, At, Bt) do { __builtin_amdgcn_s_setprio(1); _Pragma("unroll") for (int m = 0; m < 4; ++m) _Pragma("unroll") for (int n = 0; n < 2; ++n) { \
        if constexpr (FP8) asm volatile("v_mfma_scale_f32_16x16x128_f8f6f4 %0, %1, %2, %0, %3, %4 op_sel_hi:[0,0,0]" : "+v"(acc[ai][bj][m][n]) : "v"(Bt##8[n]), "v"(At##8[m]), "v"(fp8_sw), "v"(fp8_sa)); \
        else { _Pragma("unroll") for (int k = 0; k < 2; ++k) acc[ai][bj][m][n] = __builtin_amdgcn_mfma_f32_16x16x32_bf16(Bt[n][k], At[m][k], acc[ai][bj][m][n], 0, 0, 0); } } \
        __builtin_amdgcn_s_setprio(0); } while (0)
#define PG8_MMA_Z(ai, bj, At, Bt) do { __builtin_amdgcn_s_setprio(1); _Pragma("unroll") for (int m = 0; m < 4; ++m) _Pragma("unroll") for (int n = 0; n < 2; ++n) { \
        if constexpr (FP8) asm volatile("v_mfma_scale_f32_16x16x128_f8f6f4 %0, %1, %2, 0, %3, %4 op_sel_hi:[0,0,0]" : "=&v"(acc[ai][bj][m][n]) : "v"(Bt##8[n]), "v"(At##8[m]), "v"(fp8_sw), "v"(fp8_sa)); \
        else { acc[ai][bj][m][n] = __builtin_amdgcn_mfma_f32_16x16x32_bf16(Bt[n][0], At[m][0], (f32x4){0.f, 0.f, 0.f, 0.f}, 0, 0, 0); \
               acc[ai][bj][m][n] = __builtin_amdgcn_mfma_f32_16x16x32_bf16(Bt[n][1], At[m][1], acc[ai][bj][m][n], 0, 0, 0); } } \
        __builtin_amdgcn_s_setprio(0); } while (0)
#define PG8_WAIT_V(n) asm volatile("s_waitcnt vmcnt(" #n ")" ::: "memory")
#define PG8_WAIT_L(n) asm volatile("s_waitcnt lgkmcnt(" #n ")" ::: "memory")
#define PG8_BAR __builtin_amdgcn_s_barrier()
#define PG8_SCHED __builtin_amdgcn_sched_barrier(0)
    Unit cur, nxt; int ui = 0;
    if (!S.next(0, cur)) return;
    Acc acc;
#pragma unroll
    for (int a = 0; a < 2; ++a)
#pragma unroll
        for (int b = 0; b < 2; ++b)
#pragma unroll
            for (int m = 0; m < 4; ++m)
#pragma unroll
                for (int n = 0; n < 2; ++n) acc[a][b][m][n] = (f32x4){0.f, 0.f, 0.f, 0.f};
    typedef int v8i_ __attribute__((ext_vector_type(8))); typedef int v4i_ __attribute__((ext_vector_type(4)));
    bf16x8 At[4][2], B0[2][2], B1[2][2];
    v8i_ At8[4], B08[2], B18[2];
    const int fp8_sw = (int)(0x01010101u * (127u - FP8_WEXP)), fp8_sa = 0x7F7F7F7F; (void)fp8_sw; (void)fp8_sa;
    const char* cA = S.a_ptr(cur); const char* cB = S.b_ptr(cur);
    if constexpr (GATHER) { PG8_GLOAD(vC, 0); }
    if constexpr (SP2) {
        PG8_STAGE(PG8_SB(0, 0), cB, voffB); PG8_STAGE(PG8_SB(0, 1), cB + hstep, voffB); PG8_STAGE_A(PG8_SA(0, 0), cA, 0, false); PG8_STAGE_A(PG8_SA(0, 1), cA, 1, false);
        if (wr == 1) PG8_BAR;
        PG8_WAIT_V(2); PG8_BAR;
        PG8_STAGE(PG8_SB(1, 0), cB + kstep, voffB); PG8_STAGE_A(PG8_SA(1, 0), cA + kstep, 0, false); PG8_STAGE(PG8_SB(1, 1), cB + hstep + kstep, voffB);
        PG8_WAIT_V(6); PG8_BAR;
    } else {
        PG8_STAGE(PG8_SB(0, 0), cB, voffB); PG8_STAGE_A(PG8_SA(0, 0), cA, 0, false); PG8_STAGE(PG8_SB(0, 1), cB + hstep, voffB); PG8_STAGE_A(PG8_SA(0, 1), cA, 1, false);
        if (wr == 1) PG8_BAR;
        PG8_WAIT_V(4); PG8_BAR;
        PG8_STAGE(PG8_SB(1, 0), cB + kstep, voffB); PG8_STAGE_A(PG8_SA(1, 0), cA + kstep, 0, false); PG8_STAGE(PG8_SB(1, 1), cB + hstep + kstep, voffB);
        PG8_WAIT_V(6); PG8_BAR;
    }
    for (;;) {
        const bool has_next = S.next(ui + 1, nxt);
        const char* nA = has_next ? S.a_ptr(nxt) : cA; const char* nB = has_next ? S.b_ptr(nxt) : cB;
        if constexpr (SP2) {
            const int t = 0; const bool last = (t == nt - 2);
            const char* a1 = cA + (size_t)(t + 1) * kstep;
            const char* a2 = last ? nA : cA + (size_t)(t + 2) * kstep; const char* b2 = last ? nB : cB + (size_t)(t + 2) * kstep;
            const char* a3 = a2 + kstep; const char* b3 = b2 + kstep;
            PG8_LDB(B0, 0, 0); PG8_LDB(B1, 0, 1); PG8_SCHED; PG8_LDA(At, 0, 0); PG8_STAGE_A(PG8_SA(1, 1), a1, 1, false);
            if constexpr (GATHER) { if (last && has_next) { PG8_GLOAD(vC, ui + 1); } }
            PG8_WAIT_V(8); PG8_WAIT_L(0); PG8_BAR; PG8_MMA_Z(0, 0, At, B0); PG8_MMA_Z(0, 1, At, B1); PG8_BAR; PG8_SCHED;
            PG8_LDA(At, 0, 1); PG8_STAGE(PG8_SB(0, 0), b2, voffB); PG8_STAGE(PG8_SB(0, 1), b2 + hstep, voffB); PG8_STAGE_A(PG8_SA(0, 0), a2, 0, last);
            PG8_WAIT_V(8); PG8_WAIT_L(0); PG8_BAR; PG8_MMA_Z(1, 0, At, B0); PG8_MMA_Z(1, 1, At, B1); PG8_BAR; PG8_SCHED;
            PG8_LDB(B0, 1, 0); PG8_LDB(B1, 1, 1); PG8_SCHED; PG8_LDA(At, 1, 0); PG8_STAGE_A(PG8_SA(0, 1), a2, 1, last);
            PG8_WAIT_V(8); PG8_WAIT_L(0); PG8_BAR; PG8_MMA(0, 0, At, B0); PG8_MMA(0, 1, At, B1); PG8_BAR; PG8_SCHED;
            PG8_LDA(At, 1, 1); PG8_STAGE(PG8_SB(1, 0), b3, voffB); PG8_STAGE(PG8_SB(1, 1), b3 + hstep, voffB); PG8_STAGE_A(PG8_SA(1, 0), a3, 0, last);
            PG8_WAIT_V(8); PG8_WAIT_L(0); PG8_BAR; PG8_MMA(1, 0, At, B0); PG8_MMA(1, 1, At, B1); PG8_BAR; PG8_SCHED;
        }
#pragma unroll 1
        for (int t = SP2 ? 2 : 0; t < nt; t += 2) {
            const bool last = (t == nt - 2);
            const char* a1 = cA + (size_t)(t + 1) * kstep;
            const char* a2 = last ? nA : cA + (size_t)(t + 2) * kstep; const char* b2 = last ? nB : cB + (size_t)(t + 2) * kstep;
            const char* a3 = a2 + kstep; const char* b3 = b2 + kstep;
            if constexpr (SP2) {
            PG8_LDB(B0, 0, 0); PG8_LDB(B1, 0, 1); PG8_SCHED; PG8_LDA(At, 0, 0); PG8_STAGE_A(PG8_SA(1, 1), a1, 1, false);
            if constexpr (GATHER) { if (last && has_next) { PG8_GLOAD(vC, ui + 1); } }
            PG8_WAIT_V(8); PG8_WAIT_L(0); PG8_BAR; PG8_MMA(0, 0, At, B0); PG8_MMA(0, 1, At, B1); PG8_BAR; PG8_SCHED;
            PG8_LDA(At, 0, 1); PG8_STAGE(PG8_SB(0, 0), b2, voffB); PG8_STAGE(PG8_SB(0, 1), b2 + hstep, voffB); PG8_STAGE_A(PG8_SA(0, 0), a2, 0, last);
            PG8_WAIT_V(8); PG8_WAIT_L(0); PG8_BAR; PG8_MMA(1, 0, At, B0); PG8_MMA(1, 1, At, B1); PG8_BAR; PG8_SCHED;
            PG8_LDB(B0, 1, 0); PG8_LDB(B1, 1, 1); PG8_SCHED; PG8_LDA(At, 1, 0); PG8_STAGE_A(PG8_SA(0, 1), a2, 1, last);
            PG8_WAIT_V(8); PG8_WAIT_L(0); PG8_BAR; PG8_MMA(0, 0, At, B0); PG8_MMA(0, 1, At, B1); PG8_BAR; PG8_SCHED;
            PG8_LDA(At, 1, 1); PG8_STAGE(PG8_SB(1, 0), b3, voffB); PG8_STAGE(PG8_SB(1, 1), b3 + hstep, voffB); PG8_STAGE_A(PG8_SA(1, 0), a3, 0, last);
            PG8_WAIT_V(8); PG8_WAIT_L(0); PG8_BAR; PG8_MMA(1, 0, At, B0); PG8_MMA(1, 1, At, B1); PG8_BAR; PG8_SCHED;
            } else {
            PG8_LDB(B0, 0, 0); PG8_SCHED; PG8_LDA(At, 0, 0); PG8_STAGE_A(PG8_SA(1, 1), a1, 1, false);
            if constexpr (GATHER) { if (last && has_next) { PG8_GLOAD(vC, ui + 1); } }
            PG8_WAIT_L(8); PG8_BAR; PG8_WAIT_L(0); PG8_MMA(0, 0, At, B0); PG8_BAR; PG8_SCHED;
            PG8_LDB(B1, 0, 1); PG8_STAGE(PG8_SB(0, 0), b2, voffB);
            PG8_BAR; PG8_WAIT_L(0); PG8_MMA(0, 1, At, B1); PG8_BAR;
            PG8_LDA(At, 0, 1); PG8_STAGE_A(PG8_SA(0, 0), a2, 0, last);
            PG8_BAR; PG8_WAIT_L(0); PG8_MMA(1, 0, At, B0); PG8_BAR; PG8_SCHED;
            PG8_STAGE(PG8_SB(0, 1), b2 + hstep, voffB);
            PG8_WAIT_V(6); PG8_BAR; PG8_MMA(1, 1, At, B1); PG8_BAR;
            PG8_LDB(B0, 1, 0); PG8_SCHED; PG8_LDA(At, 1, 0); PG8_STAGE_A(PG8_SA(0, 1), a2, 1, last);
            PG8_WAIT_L(8); PG8_BAR; PG8_WAIT_L(0); PG8_MMA(0, 0, At, B0); PG8_BAR; PG8_SCHED;
            PG8_LDB(B1, 1, 1); PG8_STAGE(PG8_SB(1, 0), b3, voffB);
            PG8_BAR; PG8_WAIT_L(0); PG8_MMA(0, 1, At, B1); PG8_BAR;
            PG8_LDA(At, 1, 1); PG8_STAGE_A(PG8_SA(1, 0), a3, 0, last);
            PG8_BAR; PG8_WAIT_L(0); PG8_MMA(1, 0, At, B0); PG8_BAR; PG8_SCHED;
            PG8_STAGE(PG8_SB(1, 1), b3 + hstep, voffB);
            PG8_WAIT_V(6); PG8_BAR; PG8_MMA(1, 1, At, B1); PG8_BAR;
            }
        }
        if constexpr (ALIGN_EPI) { if (wr == 0) PG8_BAR; }
        if constexpr (FP8) asm volatile("s_nop 15\n\ts_nop 15" ::: "memory");
        E(acc, cur, wr, wc, ui, fq);
        if (!has_next) break;
        if constexpr (!SP2)
#pragma unroll
        for (int a = 0; a < 2; ++a)
#pragma unroll
            for (int b = 0; b < 2; ++b)
#pragma unroll
                for (int m = 0; m < 4; ++m)
#pragma unroll
                    for (int n = 0; n < 2; ++n) { typedef unsigned long long u64x2_ __attribute__((ext_vector_type(2))); u64x2_ z;
                        asm volatile("v_pk_mov_b32 %0, 0, 0" : "=v"(z.x)); asm volatile("v_pk_mov_b32 %0, 0, 0" : "=v"(z.y)); acc[a][b][m][n] = __builtin_bit_cast(f32x4, z); }
        cur = nxt; cA = nA; cB = nB; ++ui;
        if constexpr (ALIGN_EPI) { if (wr == 1) PG8_BAR; }
    }
    PG8_WAIT_V(0);
    if constexpr (!ALIGN_EPI) { if (wr == 0) PG8_BAR; }
    PG8_BAR;
#undef PG8_SA
#undef PG8_SB
#undef PG8_STAGE
#undef PG8_STAGE_A
#undef PG8_GLOAD
#undef PG8_LDA
#undef PG8_LDB
#undef PG8_MMA
#undef PG8_MMA_Z
#undef PG8_WAIT_V
#undef PG8_WAIT_L
#undef PG8_BAR
#undef PG8_SCHED
}

#define BO(p, bytes) ((decltype(p))((const char*)(p) + (unsigned)(bytes)))
#define EPI_LANE const int lane_ = lane_id(), fr = lane_ & 15, fq = lane_ >> 4; const unsigned lr = opaque((unsigned)(wr * 64 + fr)); const unsigned cw = (unsigned)(wc * 32 + 8 * fq); (void)cw
__device__ __forceinline__ void unpack8(const u32x4 w, float (&x)[8]) { x[0] = bf_lo(w.x); x[1] = bf_hi(w.x); x[2] = bf_lo(w.y); x[3] = bf_hi(w.y); x[4] = bf_lo(w.z); x[5] = bf_hi(w.z); x[6] = bf_lo(w.w); x[7] = bf_hi(w.w); }
__device__ __forceinline__ u32x4 pack8(const float (&x)[8]) { u32x4 w; w.x = pk2(x[0], x[1]); w.y = pk2(x[2], x[3]); w.z = pk2(x[4], x[5]); w.w = pk2(x[6], x[7]); return w; }
template <int ACT> struct EpiIn {
    static constexpr bool PERM = true;
    bf16* O; int ldc; const float* rstd; float* vst;
    __device__ __forceinline__ static float act(float x) {
        if (ACT == 1) { const float u = x * (1.0f + 0.044715f * x * x) * (-2.0f * 0.7978845608028654f * LOG2E); return x * frcp(1.0f + fexp2(u)); }
        return x;
    }
    __device__ __forceinline__ static f32x2 act2(f32x2 x) {
        if (ACT == 1) { const f32x2 one2 = {1.0f, 1.0f}, k2 = {0.044715f, 0.044715f}, c2 = {-2.0f * 0.7978845608028654f * LOG2E, -2.0f * 0.7978845608028654f * LOG2E};
            const f32x2 u = (x * ((x * x) * k2 + one2)) * c2; const f32x2 d = (f32x2){fexp2(u[0]), fexp2(u[1])} + one2; return x * (f32x2){frcp(d[0]), frcp(d[1])}; }
        return x;
    }
    __device__ __forceinline__ void operator()(const Acc& acc, const Unit& u, int wr, int wc, int, int) const {
        EPI_LANE;
        bf16* op = O + (size_t)u.pm * BM * ldc + (size_t)u.pn * BM; const float* rp = rstd + (size_t)u.pm * BM;
        const bool stats = (ACT == 1) && vst != nullptr && u.pn >= 4;
        float rs[2][4];
#pragma unroll
        for (int ai = 0; ai < 2; ++ai)
#pragma unroll
            for (int m = 0; m < 4; ++m) rs[ai][m] = rp[lr + (unsigned)(ai * HALF + m * 16)];
#pragma unroll
        for (int ai = 0; ai < 2; ++ai)
#pragma unroll
            for (int m = 0; m < 4; ++m) { bf16* rowp = BO(op, ((lr + (unsigned)(ai * HALF + m * 16)) * (unsigned)ldc + cw) * 2u); const float r = rs[ai][m]; float s1 = 0.f, s2 = 0.f;
#pragma unroll
                for (int bj = 0; bj < 2; ++bj) { const f32x4 v0 = acc[ai][bj][m][0] * r, v1 = acc[ai][bj][m][1] * r;
                    const f32x2 a0 = act2((f32x2){v0[0], v0[1]}), a1 = act2((f32x2){v0[2], v0[3]}), a2 = act2((f32x2){v1[0], v1[1]}), a3 = act2((f32x2){v1[2], v1[3]});
                    u32x4 w; w.x = pk2(a0[0], a0[1]); w.y = pk2(a1[0], a1[1]); w.z = pk2(a2[0], a2[1]); w.w = pk2(a3[0], a3[1]);
                    *(u32x4*)BO(rowp, bj * HALF * 2) = w;
                    if (ACT == 1) { if (stats) { float y[8]; unpack8(w, y);
#pragma unroll
                        for (int j = 0; j < 8; ++j) { s1 += y[j]; s2 += y[j] * y[j]; } } } }
                if (ACT == 1) { if (stats) { s1 += xshfl<16>(s1); s1 = sum32x(s1); s2 += xshfl<16>(s2); s2 = sum32x(s2);
                    if (fq == 0) { f32x2 st = {s1, s2}; *(f32x2*)(vst + (((size_t)u.pm * BM + lr + (unsigned)(ai * HALF + m * 16)) * 16u + (unsigned)((u.pn - 4) * 4 + wc)) * 2u) = st; } } } }
    }
};
struct EpiRes {
    static constexpr bool PERM = true;
    const bf16* Hin; bf16* Hout;
    __device__ __forceinline__ void operator()(const Acc& acc, const Unit& u, int wr, int wc, int, int) const {
        EPI_LANE;
        const size_t ub = (size_t)u.pm * BM * D + (size_t)u.pn * BM; const bf16* ip = Hin + ub; bf16* op = Hout + ub;
        u32x4 hv[2][4][2];
#pragma unroll
        for (int ai = 0; ai < 2; ++ai)
#pragma unroll
            for (int m = 0; m < 4; ++m)
#pragma unroll
                for (int bj = 0; bj < 2; ++bj) hv[ai][m][bj] = *(const u32x4*)BO(ip, ((lr + (unsigned)(ai * HALF + m * 16)) * (unsigned)D + cw + (unsigned)(bj * HALF)) * 2u);
#pragma unroll
        for (int ai = 0; ai < 2; ++ai)
#pragma unroll
            for (int m = 0; m < 4; ++m)
#pragma unroll
                for (int bj = 0; bj < 2; ++bj) { float x[8]; unpack8(hv[ai][m][bj], x); const f32x4 v0 = acc[ai][bj][m][0], v1 = acc[ai][bj][m][1];
                    x[0] += v0[0]; x[1] += v0[1]; x[2] += v0[2]; x[3] += v0[3]; x[4] += v1[0]; x[5] += v1[1]; x[6] += v1[2]; x[7] += v1[3];
                    *(u32x4*)BO(op, ((lr + (unsigned)(ai * HALF + m * 16)) * (unsigned)D + cw + (unsigned)(bj * HALF)) * 2u) = pack8(x); }
    }
};
struct EpiGU {
    static constexpr bool PERM = true;
    unsigned char* O; const LAS float* rsel;
    __device__ __forceinline__ void operator()(const Acc& acc, const Unit& u, int wr, int wc, int ui, int) const {
        EPI_LANE;
        unsigned char* op = O + (size_t)u.pm * BM * FF + (size_t)u.pn * HALF; const LAS float* rp = rsel + ui * BM;
        float rs[2][4];
#pragma unroll
        for (int ai = 0; ai < 2; ++ai)
#pragma unroll
            for (int m = 0; m < 4; ++m) rs[ai][m] = rp[lr + (unsigned)(ai * HALF + m * 16)];
        const unsigned cw16 = (unsigned)(wc * 32 + 8 * (fq & 2)), rodd = (unsigned)((fq & 1) * 16);
#pragma unroll
        for (int ai = 0; ai < 2; ++ai)
#pragma unroll
            for (int m = 0; m < 4; m += 2) { u32x2 pk[2];
#pragma unroll
                for (int mm = 0; mm < 2; ++mm) { const float rr = rs[ai][m + mm]; float r[8];
                    const f32x2 rr2 = {rr, rr}, rn2 = {-rr * LOG2E, -rr * LOG2E}, one2 = {1.0f, 1.0f};
#pragma unroll
                    for (int n = 0; n < 2; ++n)
#pragma unroll
                        for (int h = 0; h < 2; ++h) { const f32x2 ag = {acc[ai][0][m + mm][n][2 * h], acc[ai][0][m + mm][n][2 * h + 1]}, au = {acc[ai][1][m + mm][n][2 * h], acc[ai][1][m + mm][n][2 * h + 1]};
                            const f32x2 ea = ag * rn2; const f32x2 d = (f32x2){fexp2(ea[0]), fexp2(ea[1])} + one2;
                            const f32x2 o = ((ag * rr2) * (au * rr2)) * (f32x2){frcp(d[0]), frcp(d[1])};
                            r[n * 4 + 2 * h] = o[0]; r[n * 4 + 2 * h + 1] = o[1]; }
                    pk[mm] = pack8_fp8(r); }
                *(u32x4*)(op + ((lr + (unsigned)(ai * HALF + m * 16) + rodd) * (unsigned)FF + cw16)) = widen16(pk[0], pk[1]); }
    }
};
struct EpiDown {
    static constexpr bool PERM = true;
    unsigned char* O; const float* gatev;
    __device__ __forceinline__ void operator()(const Acc& acc, const Unit& u, int wr, int wc, int, int) const {
        EPI_LANE;
        unsigned char* op = O + (size_t)u.pm * BM * D + (size_t)u.pn * BM; const float* gp = gatev + (size_t)u.pm * BM;
        float gs[2][4];
#pragma unroll
        for (int ai = 0; ai < 2; ++ai)
#pragma unroll
            for (int m = 0; m < 4; ++m) gs[ai][m] = gp[lr + (unsigned)(ai * HALF + m * 16)];
        const unsigned cw16 = (unsigned)(wc * 32 + 8 * (fq & 2)), rodd = (unsigned)((fq & 1) * 16);
#pragma unroll
        for (int ai = 0; ai < 2; ++ai)
#pragma unroll
            for (int m = 0; m < 4; m += 2)
#pragma unroll
                for (int bj = 0; bj < 2; ++bj) { u32x2 pk[2];
#pragma unroll
                    for (int mm = 0; mm < 2; ++mm) { const f32x4 v0 = acc[ai][bj][m + mm][0] * gs[ai][m + mm], v1 = acc[ai][bj][m + mm][1] * gs[ai][m + mm];
                        const float x[8] = {v0[0], v0[1], v0[2], v0[3], v1[0], v1[1], v1[2], v1[3]}; pk[mm] = pack8_fp8(x); }
                    *(u32x4*)(op + ((lr + (unsigned)(ai * HALF + m * 16) + rodd) * (unsigned)D + cw16 + (unsigned)(bj * HALF))) = widen16(pk[0], pk[1]); }
    }
};
struct EpiProj {
    static constexpr bool PERM = true;
    bf16* O;
    __device__ __forceinline__ void operator()(const Acc& acc, const Unit& u, int wr, int wc, int, int) const {
        EPI_LANE;
        bf16* op = O + (size_t)u.pm * BM * D + (size_t)u.pn * BM;
#pragma unroll
        for (int ai = 0; ai < 2; ++ai)
#pragma unroll
            for (int m = 0; m < 4; ++m)
#pragma unroll
                for (int bj = 0; bj < 2; ++bj) { const f32x4 v0 = acc[ai][bj][m][0], v1 = acc[ai][bj][m][1];
                    u32x4 w; w.x = pk2(v0[0], v0[1]); w.y = pk2(v0[2], v0[3]); w.z = pk2(v1[0], v1[1]); w.w = pk2(v1[2], v1[3]);
                    *(u32x4*)BO(op, ((lr + (unsigned)(ai * HALF + m * 16)) * (unsigned)D + cw + (unsigned)(bj * HALF)) * 2u) = w; }
    }
};
struct EpiPle {
    static constexpr bool PERM = true;
    const bf16* Hc; const bf16* proj; bf16* Hn; float* outf; const float* rstd; LAS float* part; int final; unsigned char* hn8;
    __device__ __forceinline__ void operator()(const Acc& acc, const Unit& u, int wr, int wc, int, int) const {
        EPI_LANE;
        const size_t ub = (size_t)u.pm * BM * D + (size_t)u.pn * BM; const bf16* hp = Hc + ub; const bf16* pp = proj + ub; bf16* op = Hn + ub; float* fp = outf + ub; const float* rp = rstd + (size_t)u.pm * BM;
        float rs[2][4];
#pragma unroll
        for (int ai = 0; ai < 2; ++ai)
#pragma unroll
            for (int m = 0; m < 4; ++m) rs[ai][m] = rp[lr + (unsigned)(ai * HALF + m * 16)];
        u32x4 res[2][4][2];
#pragma unroll
        for (int ai = 0; ai < 2; ++ai) {
            u32x4 hv[4][2], pv[4][2];
#pragma unroll
            for (int m = 0; m < 4; ++m)
#pragma unroll
                for (int bj = 0; bj < 2; ++bj) { const unsigned o = (lr + (unsigned)(ai * HALF + m * 16)) * (unsigned)D + cw + (unsigned)(bj * HALF); hv[m][bj] = *(const u32x4*)BO(hp, o * 2u); pv[m][bj] = *(const u32x4*)BO(pp, o * 2u); }
#pragma unroll
            for (int m = 0; m < 4; ++m) { float ssq = 0.f; const float r = rs[ai][m];
#pragma unroll
                for (int bj = 0; bj < 2; ++bj) { const unsigned o = (lr + (unsigned)(ai * HALF + m * 16)) * (unsigned)D + cw + (unsigned)(bj * HALF);
                    float x[8], pj[8]; unpack8(hv[m][bj], x); unpack8(pv[m][bj], pj);
                    { const f32x2 rn2 = {-r * LOG2E, -r * LOG2E}, one2 = {1.0f, 1.0f};
#pragma unroll
                      for (int n = 0; n < 2; ++n)
#pragma unroll
                          for (int h = 0; h < 2; ++h) { const f32x2 a = {acc[ai][bj][m][n][2 * h], acc[ai][bj][m][n][2 * h + 1]}; const f32x2 ea = a * rn2;
                              const f32x2 d = (f32x2){fexp2(ea[0]), fexp2(ea[1])} + one2; const f32x2 sg = {frcp(d[0]), frcp(d[1])};
                              const f32x2 xx = (f32x2){x[4 * n + 2 * h], x[4 * n + 2 * h + 1]} + sg * (f32x2){pj[4 * n + 2 * h], pj[4 * n + 2 * h + 1]};
                              x[4 * n + 2 * h] = xx[0]; x[4 * n + 2 * h + 1] = xx[1]; } }
                    if (final) { *(f32x4*)BO(fp, o * 4u) = (f32x4){x[0], x[1], x[2], x[3]}; *(f32x4*)BO(fp, o * 4u + 16u) = (f32x4){x[4], x[5], x[6], x[7]}; }
                    else { const u32x4 w = pack8(x); res[ai][m][bj] = w; float y[8]; unpack8(w, y);
                        ssq += (y[0] * y[0] + y[1] * y[1]) + (y[2] * y[2] + y[3] * y[3]) + (y[4] * y[4] + y[5] * y[5]) + (y[6] * y[6] + y[7] * y[7]); } }
                if (!final) { ssq += xshfl<16>(ssq); ssq = sum32x(ssq); if (fq == 0) part[(lr + (unsigned)(ai * HALF + m * 16)) * 16u + (unsigned)(u.pn * 4 + wc)] = ssq; } }
        }
        if (!final) {
#pragma unroll
            for (int ai = 0; ai < 2; ++ai)
#pragma unroll
                for (int m = 0; m < 4; ++m)
#pragma unroll
                    for (int bj = 0; bj < 2; ++bj) { const unsigned o = (lr + (unsigned)(ai * HALF + m * 16)) * (unsigned)D + cw + (unsigned)(bj * HALF); *(u32x4*)BO(op, o * 2u) = res[ai][m][bj];
                        if (hn8 && (m & 1)) { float y0[8], y1[8]; unpack8(res[ai][m - 1][bj], y0); unpack8(res[ai][m][bj], y1);
                            *(u32x4*)(hn8 + ub + (lr + (unsigned)(ai * HALF + (m - 1) * 16 + (fq & 1) * 16)) * (unsigned)D + (unsigned)(wc * 32 + 8 * (fq & 2)) + (unsigned)(bj * HALF)) = widen16(pack8_fp8(y0), pack8_fp8(y1)); } }
        }
    }
};
#undef EPI_LANE
}

#define XB_TMO      128
#define XB_XCNT(j)  (256  + 64 * (j))
#define XB_XSUB(j)  (1280 + 64 * (j))
#define XB_XGEN(j)  (2304 + 64 * (j))
#define XB_TOP      3328
#define XB_TOPGEN   3392
#define XCD_BAR_WORDS 3456
#define XB_SPIN_CAP (1u << 20)
__device__ __forceinline__ unsigned xb_ld(unsigned* p)              { return __hip_atomic_load(p, __ATOMIC_RELAXED, __HIP_MEMORY_SCOPE_AGENT); }
__device__ __forceinline__ unsigned xb_add(unsigned* p, unsigned v) { return __hip_atomic_fetch_add(p, v, __ATOMIC_RELAXED, __HIP_MEMORY_SCOPE_AGENT); }
__device__ __forceinline__ unsigned xb_xcc_id() { return (unsigned)__builtin_amdgcn_s_getreg((3 << 11) | 20) & 0xFu; }
#define XB_SPIN(cond, bar) do { unsigned _sp = 0; while (cond) { __builtin_amdgcn_s_sleep(1); \
    if ((++_sp & 255u) == 0u) { if (xb_ld(&(bar)[XB_TMO])) break; if (_sp > XB_SPIN_CAP) { atomicAdd(&(bar)[XB_TMO], 1u); break; } } } } while (0)
struct XcdBarrier { unsigned* bar; unsigned x; volatile LAS unsigned* st; };
__device__ __forceinline__ XcdBarrier xcd_barrier_post(unsigned* bar, volatile LAS unsigned* st) {
    XcdBarrier b; b.bar = bar; b.x = xb_xcc_id(); b.st = st;
    if (threadIdx.x == 0) (void)xb_add(&bar[XB_XCNT(b.x)], 1u);
    return b;
}
__device__ __forceinline__ void xcd_barrier_complete(unsigned* bar, unsigned x, unsigned& nloc, unsigned& nx) {
    const unsigned G = gridDim.x * gridDim.y * gridDim.z;
    unsigned sum, cnt, mine, sp = 0u;
    for (;;) {
        sum = 0u; cnt = 0u; mine = 0u;
#pragma unroll
        for (unsigned j = 0; j < 16; ++j) { const unsigned c = xb_ld(&bar[XB_XCNT(j)]); sum += c; cnt += (c > 0u) ? 1u : 0u; mine = (j == x) ? c : mine; }
        if (sum == G) break;
        __builtin_amdgcn_s_sleep(1);
        if ((++sp & 255u) == 0u) { if (xb_ld(&bar[XB_TMO])) break; if (sp > XB_SPIN_CAP) { atomicAdd(&bar[XB_TMO], 1u); break; } }
    }
    nloc = mine > 0u ? mine : 1u; nx = cnt > 0u ? cnt : 1u;
}
__device__ __forceinline__ void xcd_barrier(const XcdBarrier& b, const int wave) {
    asm volatile("s_waitcnt vmcnt(0)" ::: "memory");
    __syncthreads();
    if (wave == 0 && lane_id() == 0) {
        unsigned* bar = b.bar;
        __builtin_amdgcn_s_waitcnt(0);
        unsigned nloc = b.st[0], nx = b.st[1];
        if (nloc == 0u) { xcd_barrier_complete(bar, b.x, nloc, nx); b.st[0] = nloc; b.st[1] = nx; }
        const unsigned old = xb_add(&bar[XB_XSUB(b.x)], 1u);
        const unsigned gen = old / nloc;
        if (old + 1u == (gen + 1u) * nloc) {
            __builtin_amdgcn_fence(__ATOMIC_RELEASE, "agent");
            asm volatile("s_waitcnt vmcnt(0)" ::: "memory");
            const unsigned og = xb_add(&bar[XB_TOP], 1u);
            const unsigned tg = og / nx;
            if (og + 1u == (tg + 1u) * nx) xb_add(&bar[XB_TOPGEN], 1u);
            else XB_SPIN(xb_ld(&bar[XB_TOPGEN]) == tg, bar);
            __builtin_amdgcn_fence(__ATOMIC_ACQUIRE, "agent");
            xb_add(&bar[XB_XGEN(b.x)], 1u);
            asm volatile("s_waitcnt vmcnt(0)" ::: "memory");
        } else {
            XB_SPIN(xb_ld(&bar[XB_XGEN(b.x)]) == gen, bar);
            __builtin_amdgcn_fence(__ATOMIC_ACQUIRE, "agent");
            asm volatile("s_waitcnt vmcnt(0)" ::: "memory");
        }
    }
    __syncthreads();
}

typedef const float* cfp_t;
typedef const __attribute__((address_space(4))) cfp_t* kin_t;
#define GIN(tab, i) ((const float*)(const GAS float*)(tab)[(i)])
struct Args { const float* in[24]; float* out; unsigned char* ws; int ph_lo, ph_hi; };
struct Frame {
    LAS unsigned char* lds;
    int tid, lane, wave, vcu, G;
    kin_t in; float* out; unsigned char* ws;
};
enum { IN_X = 0, IN_P, IN_NMIX, IN_NFFN, IN_WOUT, IN_ROUTER, IN_EG, IN_EU, IN_ED, IN_PLEN, IN_PLEG, IN_PLEP, IN_AWIN, IN_AVN, IN_AWS, IN_ABS, IN_BWIN, IN_BQN, IN_BKN, IN_BSINK, IN_CWIN, IN_CQN, IN_CKN, IN_CRPB };

__device__ __forceinline__ void transpose_item(const float* W, int K, int N, bf16* WT, int k0, int n0, int drow0, LAS float* scr, int lane, const float* gk, int fp8) {
    const int l16 = lane & 15, l4 = lane >> 4;
#pragma unroll 4
    for (int i = 0; i < 16; ++i) { const int kk = 4 * i + l4; const f32x4 v = *(const f32x4*)(W + (size_t)(k0 + kk) * N + n0 + 4 * l16); LAS float* d = scr + kk * 65 + 4 * l16; d[0] = v[0]; d[1] = v[1]; d[2] = v[2]; d[3] = v[3]; }
    LDS_WAIT(); asm volatile("" ::: "memory");
    if (fp8) {
        const int c = lane & 3; const float wsc = (float)(1 << pg8::FP8_WEXP);
        float g[16];
#pragma unroll
        for (int j = 0; j < 16; ++j) g[j] = gk ? gk[k0 + 16 * c + j] * wsc : wsc;
#pragma unroll
        for (int jj = 0; jj < 4; ++jj) { const int n = (lane >> 2) + 16 * jj; const LAS float* sp = scr + (16 * c) * 65 + n;
            float x0[8], x1[8];
#pragma unroll
            for (int j = 0; j < 8; ++j) { x0[j] = sp[j * 65] * g[j]; x1[j] = sp[(8 + j) * 65] * g[8 + j]; }
            const u32x2 a = pack8_fp8(x0), bq = pack8_fp8(x1); u32x4 o; o.x = a.x; o.y = a.y; o.z = bq.x; o.w = bq.y;
            *(u32x4*)((unsigned char*)WT + (size_t)(drow0 + n) * K + k0 + 16 * c) = o; }
    } else {
        const int c = lane & 7;
        float g[8];
#pragma unroll
        for (int j = 0; j < 8; ++j) g[j] = gk ? gk[k0 + 8 * c + j] : 1.0f;
#pragma unroll
        for (int jj = 0; jj < 8; ++jj) { const int n = (lane >> 3) + 8 * jj; const LAS float* sp = scr + (8 * c) * 65 + n;
            u32x4 o; o.x = pk2(sp[0 * 65] * g[0], sp[1 * 65] * g[1]); o.y = pk2(sp[2 * 65] * g[2], sp[3 * 65] * g[3]); o.z = pk2(sp[4 * 65] * g[4], sp[5 * 65] * g[5]); o.w = pk2(sp[6 * 65] * g[6], sp[7 * 65] * g[7]);
            *(u32x4*)(WT + (size_t)(drow0 + n) * K + k0 + 8 * c) = o; }
    }
    LDS_WAIT(); asm volatile("" ::: "memory");
}
__device__ __forceinline__ void cvt_mats(const Frame& F0, const float* W, int K, int N, int nmat, size_t src_stride, bf16* WT, size_t dst_stride, int mode, const float* gk = nullptr, int fp8 = 0) {
    Frame F = F0; F.lane = opaque_i(lane_id()); F.wave = __builtin_amdgcn_readfirstlane(opaque_i(F0.wave)); F.tid = F.wave * 64 + F.lane;
    LAS float* scr = (LAS float*)(F.lds + F.wave * 16896);
    const int gw = F.vcu * NWAVES + F.wave, NGW = F.G * NWAVES;
    const int nblk = N / 64, per = (K / 64) * nblk, total = nmat * per;
    for (int it = gw; it < total; it += NGW) {
        const int mi = it / per, r = it % per, kb = r / nblk, nb = r % nblk, n0 = 64 * nb;
        const int drow0 = mode == 0 ? n0 : ((n0 >> 7) * 256 + (n0 & 127) + (mode == 2 ? 128 : 0));
        transpose_item(W + (size_t)mi * src_stride, K, N, fp8 ? (bf16*)((unsigned char*)WT + (size_t)mi * dst_stride) : WT + (size_t)mi * dst_stride, 64 * kb, n0, drow0, scr, F.lane, gk, fp8);
    }
}
__device__ __forceinline__ void p_convert(const Frame& F) {
    for (int L = 0; L < DEPTH; ++L) {
        unsigned char* wl = F.ws + WS_W + (size_t)L * WL_STRIDE;
        const int kind = L % 3, j = L / 3;
        const float* gmix = GIN(F.in, IN_NMIX) + (size_t)L * D;
        if (kind == 0) cvt_mats(F, GIN(F.in, IN_AWIN) + (size_t)j * D * 2048, D, 2048, 1, 0, (bf16*)(wl + WL_IN), 0, 0, gmix);
        else if (kind == 1) cvt_mats(F, GIN(F.in, IN_BWIN), D, 1536, 1, 0, (bf16*)(wl + WL_IN), 0, 0, gmix, (FP8_IN_MASK >> L) & 1);
        else cvt_mats(F, GIN(F.in, IN_CWIN), D, 3072, 1, 0, (bf16*)(wl + WL_IN), 0, 0, gmix, (FP8_IN_MASK >> L) & 1);
        cvt_mats(F, GIN(F.in, IN_WOUT) + (size_t)L * D * D, D, D, 1, 0, (bf16*)(wl + WL_OUT), 0, 0);
        cvt_mats(F, GIN(F.in, IN_EG) + (size_t)L * NE * D * FF, D, FF, NE, (size_t)D * FF, (bf16*)(wl + WL_GU), (size_t)2 * FF * D, 1, GIN(F.in, IN_NFFN) + (size_t)L * D, 1);
        cvt_mats(F, GIN(F.in, IN_EU) + (size_t)L * NE * D * FF, D, FF, NE, (size_t)D * FF, (bf16*)(wl + WL_GU), (size_t)2 * FF * D, 2, GIN(F.in, IN_NFFN) + (size_t)L * D, 1);
        cvt_mats(F, GIN(F.in, IN_ED) + (size_t)L * NE * FF * D, FF, D, NE, (size_t)FF * D, (bf16*)(wl + WL_DN), (size_t)D * FF, 0, nullptr, 1);
        cvt_mats(F, GIN(F.in, IN_PLEG) + (size_t)L * D * D, D, D, 1, 0, (bf16*)(wl + WL_PG), 0, 0, GIN(F.in, IN_PLEN) + (size_t)L * D, 1);
        cvt_mats(F, GIN(F.in, IN_PLEP) + (size_t)L * PLE * D, PLE, D, 1, 0, (bf16*)(wl + WL_PP), 0, 0);
    }
    { const float* x = GIN(F.in, IN_X); bf16* hb = (bf16*)F.out; float* rstd1 = (float*)(F.ws + WS_RSTD1); const int lane = F.tid & 63;
      for (int row = F.vcu * NWAVES + F.wave; row < T; row += F.G * NWAVES) {
          const f32x4* xr = (const f32x4*)(x + (size_t)row * D) + lane; u32x2* o8 = (u32x2*)(hb + (size_t)row * D) + lane; float ss = 0.f;
#pragma unroll
          for (int q = 0; q < 4; ++q) { const f32x4 v = xr[64 * q]; u32x2 w; w.x = pk2(v[0], v[1]); w.y = pk2(v[2], v[3]); o8[64 * q] = w;
              const float y0 = bf_lo(w.x), y1 = bf_hi(w.x), y2 = bf_lo(w.y), y3 = bf_hi(w.y); ss += (y0 * y0 + y1 * y1) + (y2 * y2 + y3 * y3); }
          ss = wave_sum(ss); if (lane == 0) rstd1[row] = 1.0f / sqrtf(ss * (1.0f / D) + RMS_EPS); } }
    { const float* src = GIN(F.in, IN_AWS); bf16* dst = (bf16*)(F.ws + WS_WSA); const int n4 = 2 * 8 * 128 * 128 / 4;
      for (int i = F.vcu * NTHREADS + F.tid; i < n4; i += F.G * NTHREADS) { const f32x4 v = *(const f32x4*)(src + 4 * (size_t)i); u32x2 w; w.x = pk2(v[0], v[1]); w.y = pk2(v[2], v[3]); *(u32x2*)(dst + 4 * (size_t)i) = w; } }
}

__device__ __forceinline__ void p_router(const Frame& F0, const bf16* hb, const float* g, const float* rw, float* rstd_out, float* aff, unsigned char* hb8  ) {
    Frame F = F0; F.lane = opaque_i(lane_id()); F.wave = __builtin_amdgcn_readfirstlane(opaque_i(F0.wave)); F.tid = F.wave * 64 + F.lane;
    constexpr int WPITCH = 1032;
    LAS bf16* Whi = (LAS bf16*)F.lds; LAS bf16* Wlo = Whi + 16 * WPITCH;
    for (int i = 0; i < 32; ++i) { const int idx = F.tid + NTHREADS * i, d = idx >> 4, e = idx & 15; const float w = rw[idx] * g[d];
        const bf16 hi = f2bf(w); const bf16 lo = f2bf(w - bf1(hi)); Whi[e * WPITCH + d] = hi; Wlo[e * WPITCH + d] = lo; }
    __syncthreads();
    const int gw = F.vcu * NWAVES + F.wave, NGW = F.G * NWAVES;
    const int fr = F.lane & 15, fq = F.lane >> 4;
    for (int tile = gw; tile < T / 16; tile += NGW) {
        const size_t row = (size_t)tile * 16 + fr;
        const bf16* hp = hb + row * D + 8 * fq; unsigned char* h8 = hb8 + row * D + 8 * fq;
        f32x4 acc = {0.f, 0.f, 0.f, 0.f}; float ss = 0.f;
#pragma unroll 1
        for (int sb = 0; sb < 2; ++sb) {
            u32x4 v[16]; u32x2 p8prev = {0u, 0u};
#pragma unroll
            for (int s = 0; s < 16; ++s) v[s] = *(const u32x4*)(hp + 32 * (16 * sb + s));
#pragma unroll
            for (int s = 0; s < 16; ++s) { const u32x4 w = v[s];
                const float x0 = bf_lo(w.x), x1 = bf_hi(w.x), x2 = bf_lo(w.y), x3 = bf_hi(w.y), x4 = bf_lo(w.z), x5 = bf_hi(w.z), x6 = bf_lo(w.w), x7 = bf_hi(w.w);
                ss += (x0 * x0 + x1 * x1) + (x2 * x2 + x3 * x3) + (x4 * x4 + x5 * x5) + (x6 * x6 + x7 * x7);
                { const float xx[8] = {x0, x1, x2, x3, x4, x5, x6, x7}; const u32x2 p8 = pack8_fp8(xx);
                  if (s & 1) *(u32x4*)(hb8 + row * D + 32 * (16 * sb + s - 1 + (fq & 1)) + 8 * (fq & 2)) = widen16(p8prev, p8); else p8prev = p8; }
                const bf16x8 whi = *(const LAS bf16x8*)(Whi + fr * WPITCH + 32 * (16 * sb + s) + 8 * fq), wlo = *(const LAS bf16x8*)(Wlo + fr * WPITCH + 32 * (16 * sb + s) + 8 * fq);
                const bf16x8 hh = __builtin_bit_cast(bf16x8, w);
                acc = __builtin_amdgcn_mfma_f32_16x16x32_bf16(whi, hh, acc, 0, 0, 0);
                acc = __builtin_amdgcn_mfma_f32_16x16x32_bf16(wlo, hh, acc, 0, 0, 0); }
        }
        ss += xshfl<16>(ss); ss = sum32x(ss);
        const float rstd = 1.0f / sqrtf(ss * (1.0f / D) + RMS_EPS);
        f32x4 l = acc * rstd;
        float mx = fmaxf(fmaxf(l[0], l[1]), fmaxf(l[2], l[3])); mx = fmaxf(mx, xshfl<16>(mx)); mx = max32x(mx);
        f32x4 ev; ev[0] = __expf(l[0] - mx); ev[1] = __expf(l[1] - mx); ev[2] = __expf(l[2] - mx); ev[3] = __expf(l[3] - mx);
        float se = (ev[0] + ev[1]) + (ev[2] + ev[3]); se += xshfl<16>(se); se = sum32x(se);
        *(f32x4*)(aff + row * 16 + 4 * fq) = ev * (1.0f / se);
        if (fq == 0) rstd_out[row] = rstd;
    }
    __syncthreads();
}
__device__ __forceinline__ void p_topk(const Frame& F0, const float* aff, const float* rstd, int* idx, float* gatev, float* rsel, int* slot) {
    Frame F = F0; F.lane = opaque_i(lane_id()); F.wave = __builtin_amdgcn_readfirstlane(opaque_i(F0.wave)); F.tid = F.wave * 64 + F.lane;
    LAS unsigned* hist = (LAS unsigned*)F.lds;
    LAS unsigned* sh = hist + 256;
    for (int it = 0; ; ++it) {
        int u;
        if (F.G == 256) { if (it >= 2) break; const int x = (int)blockIdx.x & 7, jx = (int)blockIdx.x >> 3; u = ((4 * x + (jx >> 3)) << 4) | (2 * (jx & 7) + it); }
        else { u = (int)blockIdx.x + it * F.G; if (u >= NBATCH * NE) break; }
        const int b = u >> 4, e = u & 15;
        unsigned key[4];
        const float* ap = aff + ((size_t)b * SEQ + F.tid * 4) * 16 + e;
#pragma unroll
        for (int j = 0; j < 4; ++j) key[j] = __float_as_uint(ap[j * 16]);
        unsigned prefix = 0, need = CAP;
        for (int pass = 0; pass < 4; ++pass) {
            const int shift = 24 - 8 * pass;
            if (F.tid < 256) hist[F.tid] = 0;
            __syncthreads();
#pragma unroll
            for (int j = 0; j < 4; ++j) { const bool match = (pass == 0) || ((key[j] >> ((shift + 8) & 31)) == prefix); if (match) __hip_atomic_fetch_add(&hist[(key[j] >> shift) & 255u], 1u, __ATOMIC_RELAXED, __HIP_MEMORY_SCOPE_WORKGROUP); }
            __syncthreads();
            if (F.wave == 0) {
                const u32x4 h4 = *(const LAS u32x4*)(hist + 4 * F.lane); const unsigned own = (h4.x + h4.y) + (h4.z + h4.w); unsigned suf = own;
#pragma unroll
                for (int o = 1; o < 64; o <<= 1) { const unsigned t = (unsigned)__builtin_amdgcn_ds_bpermute(((F.lane + o) & 63) * 4, (int)suf); if (F.lane + o < 64) suf += t; }
                unsigned above = suf - own;
                if (above < need && suf >= need) {
                    unsigned dsel = 0, nn = 0; const unsigned hb[4] = {h4.x, h4.y, h4.z, h4.w};
#pragma unroll
                    for (int q = 3; q >= 0; --q) { if (above < need && above + hb[q] >= need) { dsel = (unsigned)(4 * F.lane + q); nn = need - above; } above += hb[q]; }
                    sh[0] = (prefix << 8) | dsel; sh[1] = nn; } }
            __syncthreads();
            prefix = sh[0]; need = sh[1];
            __syncthreads();
        }
        unsigned cg = 0, ce = 0;
#pragma unroll
        for (int j = 0; j < 4; ++j) { cg += key[j] > prefix ? 1u : 0u; ce += key[j] == prefix ? 1u : 0u; }
        const unsigned v = cg | (ce << 16); unsigned inc = v;
#pragma unroll
        for (int o = 1; o < 64; o <<= 1) { const unsigned t = (unsigned)__builtin_amdgcn_ds_bpermute(((F.lane - o) & 63) * 4, (int)inc); if (F.lane >= o) inc += t; }
        if (F.lane == 63) sh[8 + F.wave] = inc;
        __syncthreads();
        unsigned base = 0;
        for (int w = 0; w < F.wave; ++w) base += sh[8 + w];
        const unsigned exc = base + inc - v;
        unsigned pg = exc & 0xffffu, pe = exc >> 16;
        const f32x4 rs4 = *(const f32x4*)(rstd + (size_t)b * SEQ + F.tid * 4);
#pragma unroll
        for (int j = 0; j < 4; ++j) {
            const int s = F.tid * 4 + j; int c = -1;
            if (key[j] > prefix) { c = (int)(pg + (pe < need ? pe : need)); pg++; }
            else if (key[j] == prefix) { if (pe < need) c = (int)(pg + pe); pe++; }
            if (c >= 0) { idx[u * CAP + c] = s; gatev[u * CAP + c] = __uint_as_float(key[j]); rsel[u * CAP + c] = rs4[j]; }
            slot[((size_t)b * SEQ + s) * 16 + e] = c;
        }
        __syncthreads();
    }
}
__device__ __forceinline__ void p_combine(const Frame& F0, const bf16* Hin, bf16* Hout, const unsigned char* y, const int* slot, float* rstd3, const float* p, bf16* pb, unsigned char* h8) {
    Frame F = F0; F.lane = opaque_i(lane_id()); F.wave = __builtin_amdgcn_readfirstlane(opaque_i(F0.wave)); F.tid = F.wave * 64 + F.lane;
    for (int pm = (int)blockIdx.x; pm < T / 256; pm += F.G) {
        const int row0 = pm * 256 + F.wave * 32, b = row0 >> 11;
        const unsigned char* yb = y + (size_t)b * NE * CAP * D;
        u32x4 nh0, nh1; f32x4 npv; int nsl;
        { const u32x4* hr = (const u32x4*)(Hin + (size_t)row0 * D) + F.lane; nh0 = hr[0]; nh1 = hr[64]; nsl = slot[(size_t)row0 * 16 + (F.lane & 15)]; npv = *((const f32x4*)(p + (size_t)row0 * PLE) + F.lane); }
#pragma unroll 1
        for (int rr = 0; rr < 32; ++rr) {
            const int row = row0 + rr;
            const u32x4 w0 = nh0, w1 = nh1; const f32x4 pv = npv; const int sl = nsl;
            if (rr < 31) { const u32x4* hr = (const u32x4*)(Hin + (size_t)(row + 1) * D) + F.lane; nh0 = hr[0]; nh1 = hr[64]; nsl = slot[(size_t)(row + 1) * 16 + (F.lane & 15)]; npv = *((const f32x4*)(p + (size_t)(row + 1) * PLE) + F.lane); }
            float v[2][8]; pg8::unpack8(w0, v[0]); pg8::unpack8(w1, v[1]);
            unsigned m = (unsigned)__builtin_amdgcn_ballot_w64(sl >= 0) & 0xffffu;
            while (m) {
                const int e0 = __builtin_ctz(m); m &= m - 1u; const bool two = m != 0u; const int e1 = two ? __builtin_ctz(m) : e0; if (two) m &= m - 1u;
                const int c0 = __builtin_amdgcn_readlane(sl, e0), c1 = __builtin_amdgcn_readlane(sl, e1);
                const u32x2* y0 = (const u32x2*)(yb + ((size_t)(e0 * CAP + c0)) * D) + F.lane; const u32x2* y1 = (const u32x2*)(yb + ((size_t)(e1 * CAP + c1)) * D) + F.lane;
                const u32x2 a0 = y0[0], a1 = y0[64], b0 = y1[0], b1 = y1[64];
                float t0[8], t1[8]; unpack8_fp8(a0, t0); unpack8_fp8(a1, t1);
#pragma unroll
                for (int q = 0; q < 8; ++q) { v[0][q] += t0[q]; v[1][q] += t1[q]; }
                { unsigned bx0 = b0.x, bx1 = b0.y, bx2 = b1.x, bx3 = b1.y; asm volatile("" : "+v"(bx0), "+v"(bx1), "+v"(bx2), "+v"(bx3)); (void)bx0; (void)bx1; (void)bx2; (void)bx3; }
                if (two) { unpack8_fp8(b0, t0); unpack8_fp8(b1, t1);
#pragma unroll
                    for (int q = 0; q < 8; ++q) { v[0][q] += t0[q]; v[1][q] += t1[q]; } }
            }
            const u32x4 o0 = pg8::pack8(v[0]), o1 = pg8::pack8(v[1]);
            u32x4* orow = (u32x4*)(Hout + (size_t)row * D) + F.lane; orow[0] = o0; orow[64] = o1;
            float y0f[8], y1f[8]; pg8::unpack8(o0, y0f); pg8::unpack8(o1, y1f); float ss = 0.f;
#pragma unroll
            for (int q = 0; q < 8; ++q) ss += y0f[q] * y0f[q] + y1f[q] * y1f[q];
            u32x2* r8 = (u32x2*)(h8 + (size_t)row * D) + F.lane; r8[0] = pack8_fp8(y0f); r8[64] = pack8_fp8(y1f);
            ss = wave_sum(ss); if (F.lane == 0) rstd3[row] = 1.0f / sqrtf(ss * (1.0f / D) + RMS_EPS);
            u32x2 pw; pw.x = pk2(pv[0], pv[1]); pw.y = pk2(pv[2], pv[3]);
            *((u32x2*)(pb + (size_t)row * PLE) + F.lane) = pw;
        }
    }
}

__device__ __forceinline__ void p_mix_a(const Frame& F0, const bf16* z, const float* gamma, const bf16* wsb  , const float* bs  , bf16* mix, const float* vst  ) {
    Frame F = F0; F.lane = opaque_i(lane_id()); F.wave = __builtin_amdgcn_readfirstlane(opaque_i(F0.wave)); F.tid = F.wave * 64 + F.lane;
    constexpr int WP = 136, OP = 132;
    LAS float* mu = (LAS float*)F.lds; LAS float* rs = mu + 128;
    LAS bf16* WS = (LAS bf16*)(F.lds + 1024);
    LAS bf16* VN = WS + 128 * WP;
    LAS float* OUT = (LAS float*)(VN + 128 * 128);
    const int r = F.lane & 31, hh = F.lane >> 5, i16 = F.lane & 15, g16 = (F.lane >> 4) & 1;
    for (int u = blockIdx.x; u < T / 128; u += F.G) {
        const size_t tok0 = (size_t)u * 128;
        if (F.tid < 128) { const f32x4* sp = (const f32x4*)(vst + (tok0 + F.tid) * 32); float s1 = 0.f, s2 = 0.f;
#pragma unroll
            for (int q = 0; q < 8; ++q) { const f32x4 t = sp[q]; s1 += t[0]; s2 += t[1]; s1 += t[2]; s2 += t[3]; }
            const float mean = s1 * (1.0f / 1024.0f); const float var = fmaxf(s2 * (1.0f / 1024.0f) - mean * mean, 0.f);
            mu[F.tid] = mean; rs[F.tid] = 1.0f / sqrtf(var + LN_EPS); }
        const int srow = F.tid >> 4, sch = F.tid & 15;
        const bf16* zt = z + tok0 * 2048; bf16* mt = mix + tok0 * D;
        u32x4 wreg[4], vreg[4], ureg[4], unext[4];
#pragma unroll
        for (int i = 0; i < 4; ++i) { wreg[i] = *(const u32x4*)(wsb + (size_t)(srow + 32 * i) * 128 + sch * 8); vreg[i] = *(const u32x4*)(zt + (size_t)(srow + 32 * i) * 2048 + 1024 + sch * 8); ureg[i] = *(const u32x4*)(zt + (size_t)(srow + 32 * i) * 2048 + sch * 8); unext[i] = ureg[i]; }
        __syncthreads();
#pragma unroll 1
        for (int g = 0; g < 8; ++g) {
            { const f32x4 g0 = *(const f32x4*)(gamma + g * 128 + sch * 8), g1 = *(const f32x4*)(gamma + g * 128 + sch * 8 + 4);
#pragma unroll
              for (int i = 0; i < 4; ++i) { const int row = srow + 32 * i;
                  *(LAS u32x4*)(WS + row * WP + sch * 8) = wreg[i];
                  float x[8]; pg8::unpack8(vreg[i], x); const float m = mu[row], rr = rs[row];
                  x[0] = (x[0] - m) * rr * g0[0]; x[1] = (x[1] - m) * rr * g0[1]; x[2] = (x[2] - m) * rr * g0[2]; x[3] = (x[3] - m) * rr * g0[3];
                  x[4] = (x[4] - m) * rr * g1[0]; x[5] = (x[5] - m) * rr * g1[1]; x[6] = (x[6] - m) * rr * g1[2]; x[7] = (x[7] - m) * rr * g1[3];
                  *(LAS u32x4*)(VN + row * 128 + ((sch ^ ((row & 3) << 2)) * 8)) = pg8::pack8(x); } }
            __syncthreads();
#pragma unroll
            for (int i = 0; i < 4; ++i) {
                if (g < 7) { unext[i] = *(const u32x4*)(zt + (size_t)(srow + 32 * i) * 2048 + (g + 1) * 128 + sch * 8); wreg[i] = *(const u32x4*)(wsb + ((size_t)(g + 1) * 128 + srow + 32 * i) * 128 + sch * 8); vreg[i] = *(const u32x4*)(zt + (size_t)(srow + 32 * i) * 2048 + 1024 + (g + 1) * 128 + sch * 8); } }
            const int t0 = 32 * (F.wave >> 1), c0 = 64 * (F.wave & 1);
            f32x16 acc[2];
#pragma unroll
            for (int ct = 0; ct < 2; ++ct)
#pragma unroll
                for (int i = 0; i < 16; ++i) acc[ct][i] = 0.f;
#pragma unroll
            for (int ks = 0; ks < 8; ++ks) {
                const bf16x8 a = *(const LAS bf16x8*)(WS + (t0 + r) * WP + 16 * ks + 8 * hh);
                const int s0 = 16 * ks + 8 * hh + (i16 >> 2), s1 = s0 + 4;
#pragma unroll
                for (int ct = 0; ct < 2; ++ct) { const int chunk = (c0 + 32 * ct + 16 * g16) / 8 + ((i16 & 3) >> 1), h8 = 4 * (i16 & 1);
                    const s16x4 lo = __builtin_amdgcn_ds_read_tr16_b64_v4i16((LAS s16x4*)(VN + s0 * 128 + ((chunk ^ ((s0 & 3) << 2)) * 8) + h8));
                    const s16x4 hi = __builtin_amdgcn_ds_read_tr16_b64_v4i16((LAS s16x4*)(VN + s1 * 128 + ((chunk ^ ((s1 & 3) << 2)) * 8) + h8));
                    const bf16x8 bv = __builtin_shufflevector(lo, hi, 0, 1, 2, 3, 4, 5, 6, 7);
                    acc[ct] = __builtin_amdgcn_mfma_f32_32x32x16_bf16(a, bv, acc[ct], 0, 0, 0); }
            }
#pragma unroll
            for (int ct = 0; ct < 2; ++ct)
#pragma unroll
                for (int i = 0; i < 16; ++i) OUT[(t0 + (i & 3) + 8 * (i >> 2) + 4 * hh) * OP + c0 + 32 * ct + r] = acc[ct][i];
            __syncthreads();
#pragma unroll
            for (int i = 0; i < 4; ++i) { const int row = srow + 32 * i; const LAS f32x4* op = (const LAS f32x4*)(OUT + row * OP + sch * 8); const f32x4 s0v = op[0], s1v = op[1]; const float bb = bs[g * 128 + row];
                float uu[8]; pg8::unpack8(ureg[i], uu);
                uu[0] *= s0v[0] + bb; uu[1] *= s0v[1] + bb; uu[2] *= s0v[2] + bb; uu[3] *= s0v[3] + bb; uu[4] *= s1v[0] + bb; uu[5] *= s1v[1] + bb; uu[6] *= s1v[2] + bb; uu[7] *= s1v[3] + bb;
                *(u32x4*)(mt + (size_t)row * D + g * 128 + sch * 8) = pg8::pack8(uu); }
#pragma unroll
            for (int i = 0; i < 4; ++i) ureg[i] = unext[i];
        }
        __syncthreads();
    }
}

template <bool ON0, bool ON1>
__device__ __forceinline__ void mixb_tile(const int j, const LAS bf16* KS, const LAS bf16* VS, const int KP, const bf16x8 (&Qf)[2][4], f32x16 (&O)[2][2], const float (&mrun)[2], float (&lrun)[2],
                                          const int t0, const int qh, const int r, const int hh, const int i16, const int g16, const float slope2) {
    const int kt = 2 * qh + j, kb0 = 32 * kt;
    if (t0 - 128 + kb0 < 0 || t0 - 128 + kb0 >= SEQ) return;
    const int dlt0 = 32 * j - 128, dlt1 = dlt0 - 32;
    f32x16 S[2];
    bf16x8 vf[2][2];
    { f32x16 zero16;
#pragma unroll
      for (int i = 0; i < 16; ++i) zero16[i] = 0.f;
      S[0] = zero16; S[1] = zero16;
      bf16x8 kf[4];
#pragma unroll
      for (int s4 = 0; s4 < 4; ++s4) kf[s4] = *(const LAS bf16x8*)(KS + (kb0 + r) * KP + 16 * s4 + 8 * hh);
      if (ON0) {
#pragma unroll
          for (int s4 = 0; s4 < 4; ++s4) S[0] = __builtin_amdgcn_mfma_f32_32x32x16_bf16(kf[s4], Qf[0][s4], s4 ? S[0] : zero16, 0, 0, 0); }
      if (ON1) {
#pragma unroll
          for (int s4 = 0; s4 < 4; ++s4) S[1] = __builtin_amdgcn_mfma_f32_32x32x16_bf16(kf[s4], Qf[1][s4], s4 ? S[1] : zero16, 0, 0, 0); } }
#pragma unroll
    for (int s2 = 0; s2 < 2; ++s2) {
        const int k0 = kb0 + 16 * s2 + 4 * hh + (i16 >> 2), k1 = k0 + 8;
        const int sw0 = ((k0 >> 1) & 1) << 2, sw1 = ((k1 >> 1) & 1) << 2;
#pragma unroll
        for (int dt = 0; dt < 2; ++dt) { const int chunk = 4 * dt + 2 * g16 + ((i16 & 3) >> 1), h8 = 4 * (i16 & 1);
            const s16x4 lo = __builtin_amdgcn_ds_read_tr16_b64_v4i16((LAS s16x4*)(VS + k0 * 64 + ((chunk ^ sw0) * 8) + h8));
            const s16x4 hi = __builtin_amdgcn_ds_read_tr16_b64_v4i16((LAS s16x4*)(VS + k1 * 64 + ((chunk ^ sw1) * 8) + h8));
            vf[s2][dt] = __builtin_shufflevector(lo, hi, 0, 1, 2, 3, 4, 5, 6, 7); } }
#pragma unroll
    for (int qb = 0; qb < 2; ++qb) {
        const int dlt = qb ? dlt1 : dlt0; const bool on = qb ? ON1 : ON0;
        if (on) {
            const float d0 = (float)(dlt + 4 * hh - r);
            float a0 = 0.f;
            if (dlt != 0 && dlt >= -96 && dlt <= 96) {
                const float ss = dlt > 0 ? slope2 : -slope2; a0 = ss * d0;
#pragma unroll
                for (int i = 0; i < 16; ++i) S[qb][i] += ss * (float)((i & 3) + 8 * (i >> 2));
            } else if (dlt == 0) {
#pragma unroll
                for (int i = 0; i < 16; ++i) { const float rel = d0 + (float)((i & 3) + 8 * (i >> 2)); S[qb][i] += slope2 * fabsf(rel); }
            } else {
                asm volatile("" ::: "memory");
#pragma unroll
                for (int i = 0; i < 16; ++i) { const float rel = d0 + (float)((i & 3) + 8 * (i >> 2)); const float ar = fabsf(rel); S[qb][i] = ar <= 128.0f ? S[qb][i] + slope2 * ar : -1e30f; }
            }
            float ls = 0.f; const float mm = mrun[qb] - a0;
#pragma unroll
            for (int i = 0; i < 16; ++i) { const float pv = fexp2(S[qb][i] - mm); S[qb][i] = pv; ls += pv; }
            lrun[qb] += ls;
        }
    }
#pragma unroll
    for (int s2 = 0; s2 < 2; ++s2) {
        bf16x8 Pf[2];
#pragma unroll
        for (int qb = 0; qb < 2; ++qb) { u32x4 o; o.x = pk2(S[qb][8 * s2 + 0], S[qb][8 * s2 + 1]); o.y = pk2(S[qb][8 * s2 + 2], S[qb][8 * s2 + 3]); o.z = pk2(S[qb][8 * s2 + 4], S[qb][8 * s2 + 5]); o.w = pk2(S[qb][8 * s2 + 6], S[qb][8 * s2 + 7]);
            Pf[qb] = __builtin_bit_cast(bf16x8, o); }
#pragma unroll
        for (int dt = 0; dt < 2; ++dt) {
            if (ON0) O[0][dt] = __builtin_amdgcn_mfma_f32_32x32x16_bf16(vf[s2][dt], Pf[0], O[0][dt], 0, 0, 0);
            if (ON1) O[1][dt] = __builtin_amdgcn_mfma_f32_32x32x16_bf16(vf[s2][dt], Pf[1], O[1][dt], 0, 0, 0); }
    }
}
__device__ __forceinline__ void mixb_max(const int j, const LAS bf16* KS, const int KP, const bf16x8 (&Qf)[2][4], float (&mloc)[2], const int t0, const int qh, const int r, const int hh, const float slope2) {
    const int kt = 2 * qh + j, kb0 = 32 * kt;
    if (t0 - 128 + kb0 < 0 || t0 - 128 + kb0 >= SEQ) return;
    bf16x8 kf[4];
#pragma unroll
    for (int s4 = 0; s4 < 4; ++s4) kf[s4] = *(const LAS bf16x8*)(KS + (kb0 + r) * KP + 16 * s4 + 8 * hh);
#pragma unroll
    for (int qb = 0; qb < 2; ++qb) { const int dlt = 32 * j - 128 - 32 * qb;
        if (dlt > -160 && dlt < 160) {
            f32x16 S;
#pragma unroll
            for (int i = 0; i < 16; ++i) S[i] = 0.f;
#pragma unroll
            for (int s4 = 0; s4 < 4; ++s4) S = __builtin_amdgcn_mfma_f32_32x32x16_bf16(kf[s4], Qf[qb][s4], S, 0, 0, 0);
            const float d0 = (float)(dlt + 4 * hh - r); float m = qb ? mloc[1] : mloc[0];
#pragma unroll
            for (int i = 0; i < 16; ++i) { const float ar = fabsf(d0 + (float)((i & 3) + 8 * (i >> 2))); m = fmaxf(m, ar <= 128.0f ? S[i] + slope2 * ar : -1e30f); }
            if (qb) mloc[1] = m; else mloc[0] = m; } }
}
__device__ __forceinline__ void p_mix_b(const Frame& F0, const bf16* z, const float* qn_g, const float* kn_g, const float* sink, bf16* mix) {
    Frame F = F0; F.lane = opaque_i(lane_id()); F.wave = __builtin_amdgcn_readfirstlane(opaque_i(F0.wave)); F.tid = F.wave * 64 + F.lane;
    constexpr int KP = 72;
    LAS bf16* KS0 = (LAS bf16*)F.lds; LAS bf16* VS0 = KS0 + 512 * KP;
    const int r = F.lane & 31, hh = F.lane >> 5, i16 = F.lane & 15, g16 = (F.lane >> 4) & 1;
    const int g = F.wave >> 1, qh = F.wave & 1;
    volatile LAS float* sbl = (volatile LAS float*)(F.lds + 139264 + 64);
    sbl[0] = wave_max(fabsf(qn_g[F.lane])) * wave_max(fabsf(kn_g[F.lane])) * (8.0f * LOG2E * 1.02f);
    for (int u = F.vcu; u < NBATCH * 4 * 8; u += F.G) {
        const int b = u >> 5, kvh = (u >> 3) & 3, nb = ((u & 7) + 2 * (u >> 8)) & 7, t00 = nb * 256;
        const size_t tokb = (size_t)b * SEQ;
        const bf16* zu = opaque_p(z) + (tokb * 1536 + 1024 + kvh * 64); const int tidu = (int)opaque((unsigned)F.tid);
#pragma unroll
        for (int i0 = 0; i0 < 8; i0 += 8) {
        u32x4 kw4[8], vw4[8];
#pragma unroll
        for (int i = 0; i < 8; ++i) { const int q = tidu + NTHREADS * (i0 + i), row = q >> 3, ch = q & 7; const int kpos = t00 - 128 + row; const int kc = kpos < 0 ? 0 : (kpos >= SEQ ? SEQ - 1 : kpos);
            const bf16* zr = zu + (unsigned)(kc * 1536 + ch * 8); kw4[i] = *(const u32x4*)zr; vw4[i] = *(const u32x4*)(zr + 256); }
        asm volatile("" ::: "memory");
#pragma unroll
        for (int i = 0; i < 8; ++i) { const int q = tidu + NTHREADS * (i0 + i), row = q >> 3, ch = q & 7; const int kpos = t00 - 128 + row; const bool valid = kpos >= 0 && kpos < SEQ;
            u32x4 kw = kw4[i], vw = vw4[i];
            if (!valid) { kw = (u32x4){0u, 0u, 0u, 0u}; vw = (u32x4){0u, 0u, 0u, 0u}; }
            float x[8]; pg8::unpack8(kw, x);
            float ss = 0.f;
#pragma unroll
            for (int j = 0; j < 8; ++j) ss += x[j] * x[j];
            ss += xshfl<1>(ss); ss += xshfl<2>(ss); ss += xshfl<4>(ss);
            const float rstd = 1.0f / sqrtf(ss * (1.0f / 64.0f) + RMS_EPS);
            const f32x4 g0 = *(const f32x4*)(kn_g + ch * 8), g1 = *(const f32x4*)(kn_g + ch * 8 + 4);
            u32x4 o; o.x = pk2(x[0] * rstd * g0[0], x[1] * rstd * g0[1]); o.y = pk2(x[2] * rstd * g0[2], x[3] * rstd * g0[3]); o.z = pk2(x[4] * rstd * g1[0], x[5] * rstd * g1[1]); o.w = pk2(x[6] * rstd * g1[2], x[7] * rstd * g1[3]);
            *(LAS u32x4*)(KS0 + row * KP + ch * 8) = o;
            *(LAS u32x4*)(VS0 + row * 64 + ((ch ^ (((row >> 1) & 1) << 2)) * 8)) = vw; }
        }
        __syncthreads();
#pragma unroll 1
        for (int half = 0; half < 2; ++half) {
        const int t0 = t00 + 128 * half; const LAS bf16* KS = KS0 + 128 * half * KP; const LAS bf16* VS = VS0 + 128 * half * 64;
        const int head = kvh * 4 + g;
        bf16x8 Qf[2][4];
        {
            const float qscale = 0.125f * LOG2E;
#pragma unroll
            for (int qb = 0; qb < 2; ++qb) { const int tq = t0 + 64 * qh + 32 * qb + r; const bf16* zr = z + (tokb + tq) * 1536 + head * 64 + 8 * hh;
                float x[32]; float ss = 0.f;
#pragma unroll
                for (int s4 = 0; s4 < 4; ++s4) { const u32x4 w = *(const u32x4*)(zr + 16 * s4);
                    x[8 * s4 + 0] = bf_lo(w.x); x[8 * s4 + 1] = bf_hi(w.x); x[8 * s4 + 2] = bf_lo(w.y); x[8 * s4 + 3] = bf_hi(w.y); x[8 * s4 + 4] = bf_lo(w.z); x[8 * s4 + 5] = bf_hi(w.z); x[8 * s4 + 6] = bf_lo(w.w); x[8 * s4 + 7] = bf_hi(w.w); }
#pragma unroll
                for (int j = 0; j < 32; ++j) ss += x[j] * x[j];
                ss = sum32x(ss);
                const float rstd = qscale / sqrtf(ss * (1.0f / 64.0f) + RMS_EPS);
#pragma unroll
                for (int s4 = 0; s4 < 4; ++s4) { const f32x4 g0 = *(const f32x4*)(qn_g + 16 * s4 + 8 * hh), g1 = *(const f32x4*)(qn_g + 16 * s4 + 8 * hh + 4);
                    u32x4 o; o.x = pk2(x[8 * s4 + 0] * rstd * g0[0], x[8 * s4 + 1] * rstd * g0[1]); o.y = pk2(x[8 * s4 + 2] * rstd * g0[2], x[8 * s4 + 3] * rstd * g0[3]);
                    o.z = pk2(x[8 * s4 + 4] * rstd * g1[0], x[8 * s4 + 5] * rstd * g1[1]); o.w = pk2(x[8 * s4 + 6] * rstd * g1[2], x[8 * s4 + 7] * rstd * g1[3]);
                    Qf[qb][s4] = __builtin_bit_cast(bf16x8, o); } }
        }
        const float slope2 = -exp2f(-0.5f * (float)(head + 1)) * LOG2E;
        const float sk = sink[head] * LOG2E;
        const float sbound = __uint_as_float(__builtin_amdgcn_readfirstlane(__float_as_uint(sbl[0])));
        float mrun[2] = {fmaxf(sbound, sk), fmaxf(sbound, sk)};
#ifndef PROBE_TWOPASS
#define PROBE_TWOPASS 0
#endif
        if (PROBE_TWOPASS || sbound > 48.0f) {
            float mloc[2] = {sk, sk};
#pragma unroll 1
            for (int j = 0; j < 10; ++j) mixb_max(j, KS, KP, Qf, mloc, t0, qh, r, hh, slope2);
            mrun[0] = max32x(mloc[0]); mrun[1] = max32x(mloc[1]);
        }
        float lrun[2] = {hh == 0 ? fexp2(sk - mrun[0]) : 0.0f, hh == 0 ? fexp2(sk - mrun[1]) : 0.0f};
        f32x16 O[2][2];
#pragma unroll
        for (int qb = 0; qb < 2; ++qb)
#pragma unroll
            for (int dt = 0; dt < 2; ++dt)
#pragma unroll
                for (int i = 0; i < 16; ++i) O[qb][dt][i] = 0.f;
#pragma unroll 1
        for (int jj = 0; jj < 8; ++jj) {
            const int j = (jj & 1) ? 5 + (jj >> 1) : 4 - (jj >> 1);
            mixb_tile<true, true>(j, KS, VS, KP, Qf, O, mrun, lrun, t0, qh, r, hh, i16, g16, slope2);
        }
        mixb_tile<true, false>(0, KS, VS, KP, Qf, O, mrun, lrun, t0, qh, r, hh, i16, g16, slope2);
        mixb_tile<false, true>(9, KS, VS, KP, Qf, O, mrun, lrun, t0, qh, r, hh, i16, g16, slope2);
#pragma unroll
        for (int qb = 0; qb < 2; ++qb) { const float lt = sum32x(lrun[qb]); const float inv = 1.0f / lt;
            const int tq = t0 + 64 * qh + 32 * qb + r; bf16* orow = mix + (tokb + tq) * D + head * 64;
#pragma unroll
            for (int dt = 0; dt < 2; ++dt)
#pragma unroll
                for (int gp = 0; gp < 4; gp += 2) {
                    u32x2 w[2];
#pragma unroll
                    for (int k = 0; k < 2; ++k) { const int gq = gp + k; w[k].x = pk2(O[qb][dt][4 * gq + 0] * inv, O[qb][dt][4 * gq + 1] * inv); w[k].y = pk2(O[qb][dt][4 * gq + 2] * inv, O[qb][dt][4 * gq + 3] * inv); }
                    auto rx = __builtin_amdgcn_permlane32_swap(w[0].x, w[1].x, false, false); auto ry = __builtin_amdgcn_permlane32_swap(w[0].y, w[1].y, false, false);
                    u32x4 o; o.x = rx[0]; o.y = ry[0]; o.z = rx[1]; o.w = ry[1];
                    *(u32x4*)(orow + 32 * dt + 8 * gp + 8 * hh) = o; } }
        }
        __syncthreads();
    }
}

__device__ __forceinline__ void mixc_put(LAS bf16* KS, LAS bf16* VS, const u32x4 kw, const u32x4 vw, int key, int ch, const float* kn_g) {
    float x[8]; pg8::unpack8(kw, x);
    float ss = 0.f;
#pragma unroll
    for (int j = 0; j < 8; ++j) ss += x[j] * x[j];
    ss += xshfl<1>(ss); ss += xshfl<2>(ss); ss += xshfl<4>(ss);
    const float rstd = 1.0f / sqrtf(ss * (1.0f / 64.0f) + RMS_EPS);
    const f32x4 g0 = *(const f32x4*)(kn_g + ch * 8), g1 = *(const f32x4*)(kn_g + ch * 8 + 4);
    u32x4 o; o.x = pk2(x[0] * rstd * g0[0], x[1] * rstd * g0[1]); o.y = pk2(x[2] * rstd * g0[2], x[3] * rstd * g0[3]); o.z = pk2(x[4] * rstd * g1[0], x[5] * rstd * g1[1]); o.w = pk2(x[6] * rstd * g1[2], x[7] * rstd * g1[3]);
    *(LAS u32x4*)(KS + key * 64 + ((ch ^ (key & 7)) * 8)) = o;
    *(LAS u32x4*)(VS + key * 64 + ((ch ^ (((key >> 1) & 3) << 1)) * 8)) = vw;
}
__device__ __forceinline__ void p_mix_c(const Frame& F0, const bf16* z, const float* qn_g, const float* kn_g, const float* rpb, bf16* mix) {
    Frame F = F0; F.lane = opaque_i(lane_id()); F.wave = __builtin_amdgcn_readfirstlane(opaque_i(F0.wave)); F.tid = F.wave * 64 + F.lane;
    constexpr int NK = 576;
    LAS bf16* KS = (LAS bf16*)F.lds; LAS bf16* VS = KS + NK * 64; LAS float* BT = (LAS float*)(VS + NK * 64) + 16;
    const int fr = F.lane & 15, fq = F.lane >> 4;
    const int qr = F.wave >> 2, n = F.wave & 3;
    const int skc = F.tid >> 3, sch = F.tid & 7;
    for (int u = blockIdx.x; u < NBATCH * 16; u += F.G) {
      const int b = u >> 4, head = u & 15;
      const size_t tokb = (size_t)b * SEQ;
      const bf16* zk = z + tokb * 3072 + 1024 + head * 64 + sch * 8;
      const bf16* zq = z + (tokb + (size_t)(16 * n + fr)) * 3072 + head * 64 + 8 * fq;
      if (F.tid < 480) { const int r = F.tid >> 5, c = F.tid & 31; BT[F.tid] = (c < 31) ? rpb[(head * 15 + r) * 31 + c] * LOG2E : 0.f; }
      { u32x4 kw8[8], vw8[8];
#pragma unroll
        for (int row = 0; row < 8; ++row) { const bf16* zr = zk + (size_t)(row * 64 + skc) * 3072; kw8[row] = *(const u32x4*)zr; vw8[row] = *(const u32x4*)(zr + 1024); }
#pragma unroll
        for (int row = 0; row < 8; ++row) mixc_put(KS, VS, kw8[row], vw8[row], row * 64 + skc, sch, kn_g); }
      int have_hi = 7;
      u32x4 qn[2], kn[2], vn[2];
      int nnew = 0;
#pragma unroll
      for (int s = 0; s < 2; ++s) qn[s] = *(const u32x4*)(zq + (size_t)qr * 64 * 3072 + 32 * s);
      for (int rp = 0; rp < 16; ++rp) {
        const int r0 = 2 * rp;
        if (nnew > 0) mixc_put(KS, VS, kn[0], vn[0], ((have_hi + 1) % 9) * 64 + skc, sch, kn_g);
        if (nnew > 1) mixc_put(KS, VS, kn[1], vn[1], ((have_hi + 2) % 9) * 64 + skc, sch, kn_g);
        have_hi += nnew;
        const int rq = r0 + qr, cq = 16 * n + fr;
        bf16x8 Qf[2];
        { float x[16]; float ss = 0.f;
#pragma unroll
          for (int s = 0; s < 2; ++s) { const u32x4 w = qn[s];
              x[8 * s + 0] = bf_lo(w.x); x[8 * s + 1] = bf_hi(w.x); x[8 * s + 2] = bf_lo(w.y); x[8 * s + 3] = bf_hi(w.y); x[8 * s + 4] = bf_lo(w.z); x[8 * s + 5] = bf_hi(w.z); x[8 * s + 6] = bf_lo(w.w); x[8 * s + 7] = bf_hi(w.w); }
#pragma unroll
          for (int j = 0; j < 16; ++j) ss += x[j] * x[j];
          ss += xshfl<16>(ss); ss = sum32x(ss);
          const float rstd = 0.125f * LOG2E / sqrtf(ss * (1.0f / 64.0f) + RMS_EPS);
#pragma unroll
          for (int s = 0; s < 2; ++s) { const f32x4 g0 = *(const f32x4*)(qn_g + 32 * s + 8 * fq), g1 = *(const f32x4*)(qn_g + 32 * s + 8 * fq + 4);
              u32x4 o; o.x = pk2(x[8 * s + 0] * rstd * g0[0], x[8 * s + 1] * rstd * g0[1]); o.y = pk2(x[8 * s + 2] * rstd * g0[2], x[8 * s + 3] * rstd * g0[3]);
              o.z = pk2(x[8 * s + 4] * rstd * g1[0], x[8 * s + 5] * rstd * g1[1]); o.w = pk2(x[8 * s + 6] * rstd * g1[2], x[8 * s + 7] * rstd * g1[3]);
              Qf[s] = __builtin_bit_cast(bf16x8, o); } }
        __syncthreads();
        if (rp < 15) { const int nh = min(max(r0 + 3 - 4, 0), 24) + 7; nnew = nh - have_hi;
            if (nnew > 0) { const bf16* zr = zk + (size_t)((have_hi + 1) * 64 + skc) * 3072; kn[0] = *(const u32x4*)zr; vn[0] = *(const u32x4*)(zr + 1024); }
            if (nnew > 1) { const bf16* zr = zk + (size_t)((have_hi + 2) * 64 + skc) * 3072; kn[1] = *(const u32x4*)zr; vn[1] = *(const u32x4*)(zr + 1024); }
#pragma unroll
            for (int s = 0; s < 2; ++s) qn[s] = *(const u32x4*)(zq + (size_t)(r0 + 2 + qr) * 64 * 3072 + 32 * s); }
        else nnew = 0;
        const int rsq = min(max(rq - 4, 0), 24);
        const int kb = min(max(16 * n - 8, 0), 32);
        const int cs = min(max(cq - 8, 0), 48);
        const int co0 = kb + 4 * fq - cq + 15;
        const int thr = cs - kb;
        bool sel0[4]; int boff[4];
#pragma unroll
        for (int i = 0; i < 4; ++i) { sel0[i] = (4 * fq + i) >= thr; boff[i] = co0 + i + (sel0[i] ? 0 : 16); }
        f32x4 sc[8]; float mx = -1e30f;
#pragma unroll
        for (int a4 = 0; a4 < 8; a4 += 4) {
            bf16x8 kfa[4][2][2]; float bva[4][4];
#pragma unroll
            for (int a = 0; a < 4; ++a) { const int key = ((rsq + a4 + a) % 9) * 64 + kb + fr;
#pragma unroll
                for (int s = 0; s < 2; ++s) { kfa[a][0][s] = *(const LAS bf16x8*)(KS + key * 64 + (((4 * s + fq) ^ (key & 7)) * 8)); kfa[a][1][s] = *(const LAS bf16x8*)(KS + (key + 16) * 64 + (((4 * s + fq) ^ ((key + 16) & 7)) * 8)); }
                const LAS float* bt = BT + (rsq + a4 + a - rq + 7) * 32;
#pragma unroll
                for (int i = 0; i < 4; ++i) bva[a][i] = bt[boff[i]]; }
            asm volatile("" ::: "memory");
#pragma unroll
            for (int a = 0; a < 4; ++a) {
                f32x4 acc0 = {0.f, 0.f, 0.f, 0.f}, acc1 = {0.f, 0.f, 0.f, 0.f};
#pragma unroll
                for (int s = 0; s < 2; ++s) { acc0 = __builtin_amdgcn_mfma_f32_16x16x32_bf16(kfa[a][0][s], Qf[s], acc0, 0, 0, 0); acc1 = __builtin_amdgcn_mfma_f32_16x16x32_bf16(kfa[a][1][s], Qf[s], acc1, 0, 0, 0); }
                f32x4 sv;
#pragma unroll
                for (int i = 0; i < 4; ++i) { sv[i] = (sel0[i] ? acc0[i] : acc1[i]) + bva[a][i]; mx = fmaxf(mx, sv[i]); }
                sc[a4 + a] = sv; } }
        mx = fmaxf(mx, xshfl<16>(mx)); mx = max32x(mx);
        float ls = 0.f;
#pragma unroll
        for (int a8 = 0; a8 < 8; ++a8)
#pragma unroll
            for (int i = 0; i < 4; ++i) { const float pv = fexp2(sc[a8][i] - mx); sc[a8][i] = pv; ls += pv; }
        ls += xshfl<16>(ls); ls = sum32x(ls);
        const float inv = 1.0f / ls;
        f32x4 O[4];
#pragma unroll
        for (int dt = 0; dt < 4; ++dt) O[dt] = (f32x4){0.f, 0.f, 0.f, 0.f};
        const unsigned pm01 = (sel0[0] ? 0xffffu : 0u) | (sel0[1] ? 0xffff0000u : 0u), pm23 = (sel0[2] ? 0xffffu : 0u) | (sel0[3] ? 0xffff0000u : 0u);
#pragma unroll
        for (int ks = 0; ks < 8; ++ks) {
            const unsigned pa = pk2(sc[ks][0], sc[ks][1]), pb_ = pk2(sc[ks][2], sc[ks][3]);
            u32x4 o; o.x = pa & pm01; o.y = pb_ & pm23; o.z = pa & ~pm01; o.w = pb_ & ~pm23;
            const bf16x8 pf = __builtin_bit_cast(bf16x8, o);
            const int k0 = ((rsq + ks) % 9) * 64 + kb + 4 * fq + (fr >> 2), k1 = k0 + 16;
            const int sw0 = ((k0 >> 1) & 3) << 1, sw1 = ((k1 >> 1) & 3) << 1;
#pragma unroll
            for (int dt = 0; dt < 4; ++dt) { const int c16 = 2 * dt + ((fr & 3) >> 1), h8 = 4 * (fr & 1);
                const s16x4 lo = __builtin_amdgcn_ds_read_tr16_b64_v4i16((LAS s16x4*)(VS + k0 * 64 + ((c16 ^ sw0) * 8) + h8));
                const s16x4 hi = __builtin_amdgcn_ds_read_tr16_b64_v4i16((LAS s16x4*)(VS + k1 * 64 + ((c16 ^ sw1) * 8) + h8));
                const bf16x8 vf = __builtin_shufflevector(lo, hi, 0, 1, 2, 3, 4, 5, 6, 7);
                O[dt] = __builtin_amdgcn_mfma_f32_16x16x32_bf16(vf, pf, O[dt], 0, 0, 0); } }
        bf16* orow = mix + (tokb + (size_t)rq * 64 + cq) * D + head * 64;
#pragma unroll
        for (int dt = 0; dt < 4; dt += 2) { u32x2 w[2];
#pragma unroll
            for (int k = 0; k < 2; ++k) { w[k].x = pk2(O[dt + k][0] * inv, O[dt + k][1] * inv); w[k].y = pk2(O[dt + k][2] * inv, O[dt + k][3] * inv); }
            *(u32x4*)(orow + 16 * (dt + (fq & 1)) + 4 * (fq & 2)) = widen16(w[0], w[1]); }
        __syncthreads();
      }
    }
}

constexpr int NPH = 9, N_PHASES = 1 + DEPTH * NPH;
__global__ void __launch_bounds__(NTHREADS, 2) fwd(Args args) {
    extern __shared__ __attribute__((aligned(16))) unsigned char lds_raw[];
    Frame F;
    F.lds = (LAS unsigned char*)lds_raw;
    F.tid = threadIdx.x; F.lane = F.tid & 63; F.wave = __builtin_amdgcn_readfirstlane(F.tid >> 6);
    F.G = gridDim.x; { const int bx = blockIdx.x; F.vcu = (F.G % 8 == 0) ? (bx % 8) * (F.G / 8) + bx / 8 : bx; }
    F.in = (kin_t)__builtin_amdgcn_kernarg_segment_ptr(); F.out = args.out; F.ws = args.ws;
    volatile LAS unsigned* MISC = (volatile LAS unsigned*)(F.lds + MISC_OFF);
    if (F.tid < 64) MISC[F.tid] = 0u;
    __syncthreads();
    const int lo = args.ph_lo, hi = args.ph_hi;
    const bool multi = (hi - lo) > 1;
    unsigned* barw = (unsigned*)(F.ws + WS_CTL) + CW_BAR;
    XcdBarrier bar; bar.bar = barw; bar.x = 0; bar.st = nullptr;
    if (multi) bar = xcd_barrier_post(barw, MISC + 8);
#ifndef PHMASK
#define PHMASK 0xFFFFu
#endif
#define IN(k) (lo <= (k) && (k) < hi)
#define ON(k) ((PHMASK >> (k)) & 1u)
#ifndef PROBE_REPEAT
#define PROBE_REPEAT 0u
#endif
#define REP(k) ((PROBE_REPEAT >> (k)) & 1u)
#define SEAM(k) do { if (IN((k) + 1)) xcd_barrier(bar, F.wave); } while (0)

    if (ON(0) && IN(0)) { p_convert(F); if (REP(0)) p_convert(F); SEAM(0); }

#define PH_BEGIN unsigned char* ws = opaque_p(F.ws); kin_t inp = opaque_k(F.in); float* outp = opaque_p(F.out); (void)ws; (void)inp; (void)outp; \
        unsigned char* wl = ws + WS_W + (size_t)L * WL_STRIDE; (void)wl; \
        bf16* Hc = (L & 1) ? (bf16*)(ws + WS_XN) : (bf16*)outp; bf16* Hn = (L & 1) ? (bf16*)outp : (bf16*)(ws + WS_XN); (void)Hc; (void)Hn
#define P_R1 ((bf16*)(ws + WS_R1))
#define P_R2 ((bf16*)(ws + WS_R2))
#define P_HN8 ((unsigned char*)(ws + WS_R2 + 128 * MiB))
#define P_PROJ ((bf16*)(ws + WS_R1 + 128 * MiB))
#define P_HB8 ((unsigned char*)(ws + WS_R1 + 256 * MiB))
#define P_AFF ((float*)(ws + WS_AFF))
#define P_IDX ((int*)(ws + WS_IDX))
#define P_GATEV ((float*)(ws + WS_GATEV))
#define P_RSTD1 ((float*)(ws + WS_RSTD1))
#define P_RSTD ((float*)(ws + WS_RSTD))
#define P_RSTD3 ((float*)(ws + WS_RSTD3))
#define P_RSEL ((float*)(ws + WS_RSEL))
#define P_SLOT ((int*)(ws + WS_SLOT))
#ifndef MIXMASK
#define MIXMASK 7
#endif
    for (int L = 0; L < DEPTH; ++L) {
        const int pb = 1 + L * NPH, kind = L % 3, j = L / 3;
        if (ON(1) && IN(pb + 0)) { PH_BEGIN;
            const int nin = kind == 0 ? 2048 : (kind == 1 ? 1536 : 3072);
            for (int rep = 0; rep < (REP(1) ? 2 : 1); ++rep) {
            if ((FP8_IN_MASK >> L) & 1) {
                pg8::StaticOrder S; S.init(P_HN8, wl + WL_IN, T, nin, D / 2, F.G, (int)blockIdx.x);
                pg8::EpiIn<0> E{P_R1, nin, P_RSTD1, nullptr}; pg8::gemm_phase<pg8::EpiIn<0>, pg8::StaticOrder, false, true>(F.lds, F.wave, D / 2, S, E);
            } else {
            pg8::StaticOrder S; S.init(Hc, wl + WL_IN, T, nin, D, F.G, (int)blockIdx.x);
            if (kind == 0) { pg8::EpiIn<1> E{P_R1, nin, P_RSTD1, (float*)(ws + WS_VST)}; pg8::gemm_phase<pg8::EpiIn<1>, pg8::StaticOrder>(F.lds, F.wave, D, S, E); }
            else { pg8::EpiIn<0> E{P_R1, nin, P_RSTD1, nullptr}; pg8::gemm_phase<pg8::EpiIn<0>, pg8::StaticOrder>(F.lds, F.wave, D, S, E); }
            }
            }
            SEAM(pb + 0);
        }
        if (ON(2) && IN(pb + 1)) { PH_BEGIN;
#ifndef PROBE_MIXKIND
#define PROBE_MIXKIND -1
#endif
#ifndef PROBE_MIXREPN
#define PROBE_MIXREPN 2
#endif
            for (int rep = 0; rep < ((REP(2) && (PROBE_MIXKIND < 0 || PROBE_MIXKIND == kind)) ? PROBE_MIXREPN : 1); ++rep) {
            if ((MIXMASK & 1) && kind == 0) p_mix_a(F, P_R1, GIN(inp, IN_AVN) + (size_t)j * 1024, (const bf16*)(ws + WS_WSA) + (size_t)j * 8 * 128 * 128, GIN(inp, IN_ABS) + (size_t)j * 8 * 128, P_R2, (const float*)(ws + WS_VST));
            else if ((MIXMASK & 2) && kind == 1) p_mix_b(F, P_R1, GIN(inp, IN_BQN), GIN(inp, IN_BKN), GIN(inp, IN_BSINK), P_R2);
            else if ((MIXMASK & 4) && kind == 2) p_mix_c(F, P_R1, GIN(inp, IN_CQN), GIN(inp, IN_CKN), GIN(inp, IN_CRPB), P_R2);
            }
            SEAM(pb + 1);
        }
        if (ON(3) && IN(pb + 2)) { PH_BEGIN;
            if (REP(3)) { pg8::StaticOrder S; S.init(P_R2, wl + WL_OUT, T, D, D, F.G, (int)blockIdx.x);
                pg8::EpiRes E{Hc, Hn}; pg8::gemm_phase<pg8::EpiRes, pg8::StaticOrder>(F.lds, F.wave, D, S, E); }
            pg8::StaticOrder S; S.init(P_R2, wl + WL_OUT, T, D, D, F.G, (int)blockIdx.x);
            pg8::EpiRes E{Hc, Hc}; pg8::gemm_phase<pg8::EpiRes, pg8::StaticOrder>(F.lds, F.wave, D, S, E);
            SEAM(pb + 2);
        }
        if (ON(4) && IN(pb + 3)) { PH_BEGIN;
            for (int rep = 0; rep < (REP(4) ? 2 : 1); ++rep) p_router(F, Hc, GIN(inp, IN_NFFN) + (size_t)L * D, GIN(inp, IN_ROUTER) + (size_t)L * D * NE, P_RSTD, P_AFF, P_HB8);
            SEAM(pb + 3); }
        if (ON(5) && IN(pb + 4)) { PH_BEGIN;
            for (int rep = 0; rep < (REP(5) ? 2 : 1); ++rep) p_topk(F, P_AFF, P_RSTD, P_IDX, P_GATEV, P_RSEL, P_SLOT);
            SEAM(pb + 4); }
        if (ON(6) && IN(pb + 5)) { PH_BEGIN;
            for (int rep = 0; rep < (REP(6) ? 2 : 1); ++rep) {
            pg8::GroupedOrder S; S.init(P_HB8, wl + WL_GU, D / 2, 8, (size_t)2 * FF * D, F.G, (int)blockIdx.x, (size_t)SEQ * D);
            LAS unsigned short* gtab = (LAS unsigned short*)(F.lds + LDS_SPARE);
            LAS float* rtab = (LAS float*)(F.lds + LDS_SPARE + 8192);
            { const int* idx = P_IDX; const float* rsel = P_RSEL; const int tid = F.wave * 64 + lane_id();
              const unsigned* src = tid < 256 ? (const unsigned*)idx + tid : (const unsigned*)rsel + (tid - 256);
              unsigned tv[16];
#pragma unroll
              for (int i = 0; i < 16; ++i) { pg8::Unit u; const bool ok = S.next(i, u); tv[i] = ok ? src[u.pm * CAP] : 0u; }
#pragma unroll
              for (int i = 0; i < 16; ++i) { if (tid < 256) gtab[i * 256 + tid] = (unsigned short)tv[i]; else rtab[i * 256 + tid - 256] = __uint_as_float(tv[i]); }
              __syncthreads(); }
#ifndef PROBE_GU_FIXED
#define PROBE_GU_FIXED 0
#endif
            if (PROBE_GU_FIXED) { pg8::FixedTileOrder Sf; Sf.init(P_HB8, wl + WL_GU, D / 2, 8, (size_t)2 * FF * D, F.G, (int)blockIdx.x, (size_t)SEQ * D);
                pg8::EpiGU Ef{(unsigned char*)P_R2, rtab}; if (PROBE_GU_FIXED == 1) pg8::gemm_phase<pg8::EpiGU, pg8::FixedTileOrder, false, true>(F.lds, F.wave, D / 2, Sf, Ef);
                else pg8::gemm_phase<pg8::EpiGU, pg8::GroupedOrder, true, true>(F.lds, F.wave, D / 2, S, Ef, gtab); }
            pg8::EpiGU E{(unsigned char*)P_R2, rtab}; pg8::gemm_phase<pg8::EpiGU, pg8::GroupedOrder, true, true>(F.lds, F.wave, D / 2, S, E, gtab);
            }
            SEAM(pb + 5);
        }
        if (ON(7) && IN(pb + 6)) { PH_BEGIN;
            for (int rep = 0; rep < (REP(7) ? 2 : 1); ++rep) {
            pg8::GroupedOrder S; S.init(P_R2, wl + WL_DN, FF / 2, 4, (size_t)D * FF, F.G, (int)blockIdx.x);
            pg8::EpiDown E{(unsigned char*)P_R1, P_GATEV}; pg8::gemm_phase<pg8::EpiDown, pg8::GroupedOrder, false, true>(F.lds, F.wave, FF / 2, S, E);
            }
            SEAM(pb + 6);
        }
        if (ON(8) && IN(pb + 7)) { PH_BEGIN;
            if (REP(8)) p_combine(F, Hc, Hn, (const unsigned char*)P_R1, P_SLOT, P_RSTD3, GIN(inp, IN_P) + (size_t)L * T * PLE, P_R2, P_HB8);
            p_combine(F, Hc, Hc, (const unsigned char*)P_R1, P_SLOT, P_RSTD3, GIN(inp, IN_P) + (size_t)L * T * PLE, P_R2, P_HB8);
            VM_WAIT(); __syncthreads(); __builtin_amdgcn_fence(__ATOMIC_ACQUIRE, "agent"); VM_WAIT(); __syncthreads(); }
        if (ON(9) && IN(pb + 8)) {
#ifndef PROBE_PLEPART
#define PROBE_PLEPART 3
#endif
            for (int rep = 0; rep < (REP(9) ? 2 : 1); ++rep) {
            if (rep == 0 || (PROBE_PLEPART & 1))
            { PH_BEGIN; pg8::PanelOrder S; S.init(P_R2, wl + WL_PP, PLE, T / 256, D / 256, F.G, (int)blockIdx.x);
              pg8::EpiProj E{P_PROJ}; pg8::gemm_phase<pg8::EpiProj, pg8::PanelOrder>(F.lds, F.wave, PLE, S, E); }
            if (rep == 0 || (PROBE_PLEPART & 2)) {
            __builtin_amdgcn_fence(__ATOMIC_ACQUIRE, "agent");
            { PH_BEGIN; pg8::PanelOrder S; S.init(P_HB8, wl + WL_PG, D / 2, T / 256, D / 256, F.G, (int)blockIdx.x);
              LAS float* part = (LAS float*)(F.lds + LDS_SPARE);
              pg8::EpiPle E{Hc, P_PROJ, Hn, outp, P_RSTD3, part, L == DEPTH - 1 ? 1 : 0, (L + 1 < DEPTH && ((FP8_IN_MASK >> (L + 1)) & 1)) ? P_HN8 : (unsigned char*)nullptr}; pg8::gemm_phase<pg8::EpiPle, pg8::PanelOrder, false, true>(F.lds, F.wave, D / 2, S, E);
              if (L != DEPTH - 1) {
                  __syncthreads();
                  const int tid = F.wave * 64 + lane_id();
                  if (tid < 256) { const LAS f32x4* pr = (const LAS f32x4*)(part + tid * 16); const f32x4 a = pr[0], b = pr[1], c = pr[2], d = pr[3];
                      const float ss = ((a[0] + a[1]) + (a[2] + a[3])) + ((b[0] + b[1]) + (b[2] + b[3])) + ((c[0] + c[1]) + (c[2] + c[3])) + ((d[0] + d[1]) + (d[2] + d[3]));
                      P_RSTD1[(size_t)blockIdx.x * 256 + tid] = 1.0f / sqrtf(ss * (1.0f / D) + RMS_EPS); }
                  __syncthreads(); } }
            }
            }
            SEAM(pb + 8);
        }
    }
#undef IN
#undef SEAM
}

extern "C" void kernel_launch(void* const* d_in, const int* in_sizes, int n_in, void* d_out, int out_size, void* d_ws, size_t ws_size, hipStream_t stream) {
    static int grid = 0;
    if (grid == 0) {
        if (n_in != 24 || out_size != T * D || ws_size < WS_END) { fprintf(stderr, "kernel_launch: unexpected shapes: n_in %d out %d ws %zu (need %zu)\n", n_in, out_size, ws_size, (size_t)WS_END); grid = -1; return; }
        int dev = 0, cus = 0, per_cu = 0;
        if (hipGetDevice(&dev) != hipSuccess || hipDeviceGetAttribute(&cus, hipDeviceAttributeMultiprocessorCount, dev) != hipSuccess) { grid = -1; return; }
        if (hipFuncSetAttribute((const void*)fwd, hipFuncAttributeMaxDynamicSharedMemorySize, LDS_BYTES) != hipSuccess) { fprintf(stderr, "kernel_launch: hipFuncSetAttribute failed\n"); grid = -1; return; }
        if (hipOccupancyMaxActiveBlocksPerMultiprocessor(&per_cu, (const void*)fwd, NTHREADS, LDS_BYTES) != hipSuccess || per_cu < 1) fprintf(stderr, "kernel_launch: occupancy query reports %d\n", per_cu);
        (void)hipGetLastError();
        grid = cus;
        if (grid != 256) fprintf(stderr, "kernel_launch: built for a 256-CU device (one workgroup per 256-row panel); got %d CUs\n", cus);
    }
    if (grid < 0) return;
    (void)hipMemsetAsync((char*)d_ws + WS_CTL, 0, CTL_ZERO_BYTES, stream);
    Args a{};
    for (int i = 0; i < 24; ++i) a.in[i] = (const float*)d_in[i];
    a.out = (float*)d_out; a.ws = (unsigned char*)d_ws;
#if MK_ONE_LAUNCH
    a.ph_lo = 0; a.ph_hi = N_PHASES;
    hipLaunchKernelGGL(fwd, dim3(grid), dim3(NTHREADS), LDS_BYTES, stream, a);
#else
    for (int k = 0; k < N_PHASES; ++k) { a.ph_lo = k; a.ph_hi = k + 1; hipLaunchKernelGGL(fwd, dim3(grid), dim3(NTHREADS), LDS_BYTES, stream, a); }
#endif
}
```
